# Optimizing an MI355X kernel written in HIP

```python
import jax, jax.numpy as jnp
from jax import lax
import numpy as np

D_MODEL = 1024
BATCH = 8
SEQ = 2048
DEPTH = 1
DEC_BATCH = 128
DEC_SEQ = 4
PAST_LEN = 8192
PAGE_SIZE = 128

HEAD_DIM = 64
A_HEADS = 8
A_KV_HEADS = 2
A_WINDOW = 128
B_GROUPS = ((128, 1), (512, 4), (2048, 16))
B_HEADS_PER_GROUP = 4
B_HEADS = 3 * B_HEADS_PER_GROUP
D_FF = 4 * D_MODEL
CONV_W = 3
BLOCK = 128
RMS_EPS = 1e-6
NEG_INF = -1e30
QA = A_HEADS * HEAD_DIM
KVA = A_KV_HEADS * HEAD_DIM
QB = B_HEADS * HEAD_DIM
B_OUT = B_HEADS_PER_GROUP * HEAD_DIM
IN_SPLITS = (QA, KVA, KVA, QB, QB, QB, D_MODEL, D_MODEL)
IN_COLS = QA + 2 * KVA + 3 * QB + 2 * D_MODEL

kernel_name = "hybrid_swa_sink_dilated_convffn_step"

F32 = jnp.float32


def rmsnorm(x, gain):
    xf = x.astype(F32)
    y = xf * lax.rsqrt(jnp.mean(xf * xf, axis=-1, keepdims=True) + RMS_EPS)
    return (y * gain.astype(F32)).astype(x.dtype)


def alibi_slopes(n_heads):
    return jnp.exp2(-8.0 * jnp.arange(1, n_heads + 1, dtype=F32) / n_heads)


def softmax_stats(s, snk):
    m = jnp.max(s, axis=-1)
    if snk is not None:
        m = jnp.maximum(m, snk)
    p = jnp.exp(s - m[..., None])
    l = jnp.sum(p, axis=-1)
    if snk is not None:
        l = l + jnp.exp(snk - m)
    return p, l, m + jnp.log(l)


def banded_attention(q, k, v, slopes, max_dist, dist_scale, sinks=None):
    n, L, hq, hd = q.shape
    hk = k.shape[2]
    rep = hq // hk
    nb = -(-L // BLOCK)
    pad = nb * BLOCK - L
    qb = jnp.pad(q, ((0, 0), (0, pad), (0, 0), (0, 0))).reshape(n, nb, BLOCK, hk, rep, hd)

    def two_blocks(t):
        tb = jnp.pad(t, ((0, 0), (BLOCK, pad), (0, 0), (0, 0))).reshape(n, nb + 1, BLOCK, hk, hd)
        return jnp.concatenate([tb[:, :-1], tb[:, 1:]], axis=2)

    k2, v2 = two_blocks(k), two_blocks(v)
    s = jnp.einsum('nbqgrd,nbkgd->nbgrqk', qb.astype(F32), k2.astype(F32)) * (HEAD_DIM ** -0.5)
    dist = (jnp.arange(BLOCK)[:, None] + BLOCK) - jnp.arange(2 * BLOCK)[None, :]
    key_pos = jnp.arange(nb)[:, None] * BLOCK + jnp.arange(2 * BLOCK)[None, :] - BLOCK
    valid = ((dist >= 0) & (dist <= max_dist))[None] & (key_pos >= 0)[:, None, :]
    bias = -slopes.astype(F32).reshape(hk, rep)[:, :, None, None] * (dist * dist_scale).astype(F32)
    s = jnp.where(valid[None, :, None, None], s + bias, NEG_INF)
    snk = None if sinks is None else sinks.astype(F32).reshape(hk, rep, 1)
    p, l, lse = softmax_stats(s, snk)
    o = jnp.einsum('nbgrqk,nbkgd->nbqgrd', p, v2.astype(F32)) / jnp.moveaxis(l, -1, 2)[..., None]
    o = o.reshape(n, nb * BLOCK, hq, hd)[:, :L]
    lse = jnp.moveaxis(lse, -1, 2).reshape(n, nb * BLOCK, hq)[:, :L]
    return o, lse


def dilated_prompt_attention(q, k, v, slopes, window, dil):
    n, L, h, hd = q.shape
    ls = L // dil

    def to_sub(t):
        return t.reshape(n, ls, dil, h, hd).transpose(0, 2, 1, 3, 4).reshape(n * dil, ls, h, hd)

    o, lse = banded_attention(to_sub(q), to_sub(k), to_sub(v), slopes, window // dil, dil)
    o = o.reshape(n, dil, ls, h, hd).transpose(0, 2, 1, 3, 4).reshape(n, L, h, hd)
    lse = lse.reshape(n, dil, ls, h).transpose(0, 2, 1, 3).reshape(n, L, h)
    return o, lse


def gathered_window_attention(q, k_buf, v_buf, k_new, v_new, slopes, max_dist, dil, sinks=None):
    n, t, hq, hd = q.shape
    hk = k_new.shape[2]
    rep = hq // hk
    wb = k_buf.shape[1]
    kf = jnp.concatenate([k_buf.astype(k_new.dtype), k_new], axis=1)
    vf = jnp.concatenate([v_buf.astype(v_new.dtype), v_new], axis=1)
    steps = jnp.arange(max_dist + 1)
    idx = wb + jnp.arange(t)[:, None] - steps[None, :] * dil
    valid = idx >= 0
    idx = jnp.maximum(idx, 0)
    kg, vg = kf[:, idx], vf[:, idx]
    qg = q.reshape(n, t, hk, rep, hd)
    s = jnp.einsum('ntgrd,ntkgd->ngrtk', qg.astype(F32), kg.astype(F32)) * (HEAD_DIM ** -0.5)
    bias = -slopes.astype(F32).reshape(hk, rep)[:, :, None, None] * (steps * dil).astype(F32)
    s = jnp.where(valid, s + bias, NEG_INF)
    snk = None if sinks is None else sinks.astype(F32).reshape(hk, rep, 1)
    p, l, lse = softmax_stats(s, snk)
    o = jnp.einsum('ngrtk,ntkgd->ntgrd', p, vg.astype(F32)) / jnp.moveaxis(l, -1, 1)[..., None]
    return o.reshape(n, t, hq, hd), jnp.moveaxis(lse, -1, 1).reshape(n, t, hq)


def window_update(prev_kv, k, v, window):
    full = jnp.concatenate([prev_kv.astype(k.dtype), jnp.stack([k, v], axis=2)], axis=1)
    keep = min(window, full.shape[1])
    return full[:, full.shape[1] - keep:]


def in_project(h, w_in):
    n, t, _ = h.shape
    cuts = np.cumsum(IN_SPLITS)[:-1].tolist()
    qa, ka, va, qb, kb, vb, ga, gb = jnp.split(jnp.einsum('ntd,dc->ntc', h, w_in), cuts, axis=-1)
    heads = lambda z, nh: z.reshape(n, t, nh, HEAD_DIM)
    return (heads(qa, A_HEADS), heads(ka, A_KV_HEADS), heads(va, A_KV_HEADS),
            heads(qb, B_HEADS), heads(kb, B_HEADS), heads(vb, B_HEADS), ga, gb)


def token_mixer(h, caches, w_in, sinks_a, w_branch_a, w_branch_b, w_out):
    n, t, _ = h.shape
    qa, ka, va, qb, kb, vb, ga, gb = in_project(h, w_in)
    slopes_a, slopes_b = alibi_slopes(A_HEADS), alibi_slopes(B_HEADS)
    if caches is None:
        prev = [jnp.zeros((n, 0, 2, A_KV_HEADS, HEAD_DIM), h.dtype)] + \
               [jnp.zeros((n, 0, 2, B_HEADS_PER_GROUP, HEAD_DIM), h.dtype)] * len(B_GROUPS)
        o_a, _ = banded_attention(qa, ka, va, slopes_a, A_WINDOW - 1, 1, sinks_a)
    else:
        prev = list(caches)
        o_a, _ = gathered_window_attention(qa, prev[0][:, :, 0], prev[0][:, :, 1], ka, va,
                                           slopes_a, A_WINDOW - 1, 1, sinks_a)
    new = [window_update(prev[0], ka, va, A_WINDOW)]
    outs, lses = [], []
    for g, (win, dil) in enumerate(B_GROUPS):
        hs = slice(g * B_HEADS_PER_GROUP, (g + 1) * B_HEADS_PER_GROUP)
        qg, kg, vg, sg = qb[:, :, hs], kb[:, :, hs], vb[:, :, hs], slopes_b[hs]
        if caches is None:
            o, lse = dilated_prompt_attention(qg, kg, vg, sg, win, dil)
        else:
            c = prev[g + 1]
            o, lse = gathered_window_attention(qg, c[:, :, 0], c[:, :, 1], kg, vg, sg, win // dil, dil)
        outs.append(o)
        lses.append(lse)
        new.append(window_update(prev[g + 1], kg, vg, win))
    wts = jax.nn.softmax(jnp.stack(lses, axis=0), axis=0)
    o_b = jnp.sum(wts[..., None] * jnp.stack(outs, axis=0), axis=0)
    y_a = jnp.einsum('ntc,cd->ntd', o_a.reshape(n, t, QA).astype(h.dtype), w_branch_a)
    y_b = jnp.einsum('ntc,cd->ntd', o_b.reshape(n, t, B_OUT).astype(h.dtype), w_branch_b)
    mixed = jax.nn.sigmoid(ga) * y_a + jax.nn.sigmoid(gb) * y_b
    return jnp.einsum('ntd,de->nte', mixed, w_out), new


def conv_ffn(h, conv_prev, w_up, conv_w, conv_b, w_down):
    t = h.shape[1]
    a, g = jnp.split(jnp.einsum('ntd,df->ntf', h, w_up), 2, axis=-1)
    ap = jnp.concatenate([conv_prev.astype(a.dtype), a], axis=1)
    c = conv_b
    for j in range(CONV_W):
        c = c + conv_w[j] * ap[:, j:j + t]
    y = jnp.einsum('ntf,fd->ntd', jax.nn.gelu(c, approximate=True) * g, w_down)
    return y, ap[:, t:]


def decoder_layer(x, caches, conv_prev, w_in, sinks_a, w_branch_a, w_branch_b, w_out,
                  g_mix_pre, g_mix_post, g_ffn_pre, g_ffn_post, w_up, conv_w, conv_b, w_down):
    mix, new_kv = token_mixer(rmsnorm(x, g_mix_pre), caches, w_in, sinks_a, w_branch_a, w_branch_b, w_out)
    x = x + rmsnorm(mix, g_mix_post)
    f, new_conv = conv_ffn(rmsnorm(x, g_ffn_pre), conv_prev, w_up, conv_w, conv_b, w_down)
    x = x + rmsnorm(f, g_ffn_post)
    return x, new_kv + [new_conv]


def setup_inputs(seed: int = 0) -> dict:
    key = jax.random.key(seed)
    ks = jax.random.split(key, 24)
    nrm = lambda k, shape, scale: jax.random.normal(k, shape, F32) * scale
    bh = B_HEADS_PER_GROUP
    return {
        "x_prompt": nrm(ks[0], (BATCH, SEQ, D_MODEL), 1.0),
        "x_sample": nrm(ks[1], (DEC_BATCH, DEC_SEQ, D_MODEL), 1.0),
        "cache_a_kv": nrm(ks[2], (DEPTH, DEC_BATCH, min(A_WINDOW, PAST_LEN), 2, A_KV_HEADS, HEAD_DIM), 1.0),
        "cache_b1_kv": nrm(ks[3], (DEPTH, DEC_BATCH, min(B_GROUPS[0][0], PAST_LEN), 2, bh, HEAD_DIM), 1.0),
        "cache_b2_kv": nrm(ks[4], (DEPTH, DEC_BATCH, min(B_GROUPS[1][0], PAST_LEN), 2, bh, HEAD_DIM), 1.0),
        "cache_b3_kv": nrm(ks[5], (DEPTH, DEC_BATCH, min(B_GROUPS[2][0], PAST_LEN), 2, bh, HEAD_DIM), 1.0),
        "state_conv": nrm(ks[6], (DEPTH, DEC_BATCH, CONV_W - 1, D_FF), 1.0),
        "w_in": nrm(ks[7], (DEPTH, D_MODEL, IN_COLS), D_MODEL ** -0.5),
        "sinks_a": nrm(ks[8], (DEPTH, A_HEADS), 0.5),
        "w_branch_a": nrm(ks[9], (DEPTH, QA, D_MODEL), QA ** -0.5),
        "w_branch_b": nrm(ks[10], (DEPTH, B_OUT, D_MODEL), B_OUT ** -0.5),
        "w_out": nrm(ks[11], (DEPTH, D_MODEL, D_MODEL), D_MODEL ** -0.5),
        "norm_mix_pre": 1.0 + nrm(ks[12], (DEPTH, D_MODEL), 0.05),
        "norm_mix_post": 1.0 + nrm(ks[13], (DEPTH, D_MODEL), 0.05),
        "norm_ffn_pre": 1.0 + nrm(ks[14], (DEPTH, D_MODEL), 0.05),
        "norm_ffn_post": 1.0 + nrm(ks[15], (DEPTH, D_MODEL), 0.05),
        "w_up": nrm(ks[16], (DEPTH, D_MODEL, 2 * D_FF), D_MODEL ** -0.5),
        "conv_w": nrm(ks[17], (DEPTH, CONV_W, D_FF), CONV_W ** -0.5),
        "conv_b": nrm(ks[18], (DEPTH, D_FF), 0.02),
        "w_down": nrm(ks[19], (DEPTH, D_FF, D_MODEL), D_FF ** -0.5),
    }


def reference(x_prompt, x_sample, cache_a_kv, cache_b1_kv, cache_b2_kv, cache_b3_kv, state_conv,
              w_in, sinks_a, w_branch_a, w_branch_b, w_out, norm_mix_pre, norm_mix_post,
              norm_ffn_pre, norm_ffn_post, w_up, conv_w, conv_b, w_down):
    yp, ys = x_prompt, x_sample
    new_p = [[] for _ in range(5)]
    new_s = [[] for _ in range(5)]
    for l in range(DEPTH):
        wts = (w_in[l], sinks_a[l], w_branch_a[l], w_branch_b[l], w_out[l], norm_mix_pre[l],
               norm_mix_post[l], norm_ffn_pre[l], norm_ffn_post[l], w_up[l], conv_w[l], conv_b[l], w_down[l])
        conv0 = jnp.zeros((yp.shape[0], CONV_W - 1, D_FF), yp.dtype)
        yp, sp = decoder_layer(yp, None, conv0, *wts)
        ys, ss = decoder_layer(ys, (cache_a_kv[l], cache_b1_kv[l], cache_b2_kv[l], cache_b3_kv[l]),
                               state_conv[l], *wts)
        for i in range(5):
            new_p[i].append(sp[i])
            new_s[i].append(ss[i])
    sp = [jnp.stack(v, axis=0) for v in new_p]
    ss = [jnp.stack(v, axis=0) for v in new_s]
    return (yp, ys, sp[0], ss[0], sp[1], ss[1], sp[2], ss[2], sp[3], ss[3], sp[4], ss[4])
```

```cpp
#include <hip/hip_runtime.h>
#include <hip/hip_cooperative_groups.h>
#include <cstdio>
#include <cstdint>
namespace cg = cooperative_groups;
namespace pg8 {
#define PG8_LAS __attribute__((address_space(3)))
typedef unsigned short bf16_t;
typedef short bf16x8 __attribute__((ext_vector_type(8)));
typedef float f32x4 __attribute__((ext_vector_type(4)));
typedef unsigned u32x4 __attribute__((ext_vector_type(4)));
constexpr int BM = 256, BK = 64, HALF = 128, HTB = HALF * BK * 2  , STAGE_BYTES = 8 * HTB, NXCD = 8, WGM = 8;

__host__ __device__ __forceinline__ int lds_byte(int r, int c) { const int st = (r >> 4) * 2 + (c >> 5), rr = r & 15, cc = c & 31, ob = rr * 64 + cc * 2; return st * 1024 + (ob ^ (((ob >> 9) & 1) << 5)); }
__host__ __device__ __forceinline__ void stage_rc(int b, int& R, int& C) { const int st = b / 1024, sb = b % 1024, swz = sb ^ (((sb >> 9) & 1) << 5); R = (st >> 1) * 16 + swz / 64; C = (st & 1) * 32 + (swz % 64) / 2; }
__host__ __device__ __forceinline__ int perm32(int rho) { const int n = rho >> 4, i = rho & 15; return 8 * (i >> 2) + 4 * n + (i & 3); }

struct Unit { int pm, pn, kofs, nt; };
struct Gemm { const bf16_t* A; const bf16_t* Bt; int M, N, K; };

struct StaticOrder {
    int nM, nN, nwg, G, c, ntf;
    __host__ __device__ void init(int M, int N, int G_, int c_) { nM = M / BM; nN = N / BM; nwg = nM * nN; G = G_; c = c_; }
    __host__ __device__ bool next(int i, Unit& u) const {
        const long L = (long)i * G + c; if (L >= nwg) return false;
        int wgid = (int)L; { const int q = nwg / NXCD, r = nwg % NXCD, xcd = wgid % NXCD, off = wgid / NXCD; wgid = (xcd < r ? xcd * (q + 1) : r * (q + 1) + (xcd - r) * q) + off; }
        const int nig = WGM * nN, gid = wgid / nig, fm = gid * WGM, gsz = (nM - fm) < WGM ? (nM - fm) : WGM;
        u.pm = fm + ((wgid % nig) % gsz); u.pn = (wgid % nig) / gsz; u.kofs = 0; u.nt = ntf; return true;
    }
    __device__ __forceinline__ void a_ready(const Unit&) const {}
    __device__ __forceinline__ void done(const Unit&) const {}
};
__device__ __forceinline__ unsigned cvt_pk_bf16(float lo, float hi) { unsigned r; asm volatile("v_cvt_pk_bf16_f32 %0, %1, %2" : "=v"(r) : "v"(lo), "v"(hi)); return r; }
template <class Epi, class Sched, bool ALIGN_EPI = false, bool SP2 = false>
__device__ __forceinline__ void gemm_phase(PG8_LAS unsigned char* lds, const Gemm g, const Sched& S, const Epi& E) {
    const int tid = threadIdx.x, wid = __builtin_amdgcn_readfirstlane(tid >> 6), lane = tid & 63, wr = wid >> 2, wc = wid & 3, fr = lane & 15, fq = lane >> 4;
    const int K = g.K;
    unsigned voffA[2], voffB[2];
#pragma unroll
    for (int i = 0; i < 2; ++i) { int R, C; stage_rc(tid * 16 + i * 8192, R, C); const int Rb = Epi::PERM ? ((R & ~31) + perm32(R & 31)) : R;
        voffA[i] = (unsigned)(R * K + C) * 2u; voffB[i] = (unsigned)(Rb * K + C) * 2u; }
    const size_t kstep = (size_t)(BK * 2);
    const size_t hstep = (size_t)HALF * K * 2;
    const size_t tstep = 2 * hstep;
    const unsigned ldsw = (unsigned)wid * 1024u;
    const int aoff = lds_byte(wr * 64 + fr, fq * 8), boff = lds_byte(wc * 32 + fr, fq * 8);
#define PG8_SA(b, h) (((b) * 2 + (h)) * HTB)
#define PG8_SB(b, h) ((4 + (b) * 2 + (h)) * HTB)
#define PG8_STAGE(bufoff, gbase, voff) do { _Pragma("unroll") for (int _i = 0; _i < 2; ++_i) \
        __builtin_amdgcn_global_load_lds((const unsigned*)((const char*)(gbase) + (voff)[_i]), (PG8_LAS unsigned*)(lds + (bufoff) + ldsw + _i * 8192), 16, 0, 0); } while (0)
#define PG8_LDA(dst, b, h) do { _Pragma("unroll") for (int m = 0; m < 4; ++m) _Pragma("unroll") for (int k = 0; k < 2; ++k) dst[m][k] = *(const PG8_LAS bf16x8*)(lds + PG8_SA(b, h) + aoff + m * 2048 + k * 1024); } while (0)
#define PG8_LDB(dst, b, h) do { _Pragma("unroll") for (int n = 0; n < 2; ++n) _Pragma("unroll") for (int k = 0; k < 2; ++k) dst[n][k] = *(const PG8_LAS bf16x8*)(lds + PG8_SB(b, h) + boff + n * 2048 + k * 1024); } while (0)
#define PG8_MMA(ai, bj, At, Bt) do { __builtin_amdgcn_s_setprio(1); _Pragma("unroll") for (int m = 0; m < 4; ++m) _Pragma("unroll") for (int n = 0; n < 2; ++n) _Pragma("unroll") for (int k = 0; k < 2; ++k) \
        acc[ai][bj][m][n] = __builtin_amdgcn_mfma_f32_16x16x32_bf16(Bt[n][k], At[m][k], acc[ai][bj][m][n], 0, 0, 0); __builtin_amdgcn_s_setprio(0); } while (0)
#define PG8_WAIT_V(n) asm volatile("s_waitcnt vmcnt(" #n ")" ::: "memory")
#define PG8_WAIT_L(n) asm volatile("s_waitcnt lgkmcnt(" #n ")" ::: "memory")
#define PG8_BAR __builtin_amdgcn_s_barrier()
#define PG8_SCHED __builtin_amdgcn_sched_barrier(0)
    Unit cur, nxt; int ui = 0;
    if (!S.next(0, cur)) return;
    f32x4 acc[2][2][4][2];
#pragma unroll
    for (int a = 0; a < 2; ++a)
#pragma unroll
        for (int b = 0; b < 2; ++b)
#pragma unroll
            for (int m = 0; m < 4; ++m)
#pragma unroll
                for (int n = 0; n < 2; ++n) acc[a][b][m][n] = (f32x4){0.f, 0.f, 0.f, 0.f};
    bf16x8 At[4][2], B0[2][2], B1[2][2];
    const char* cA = (const char*)g.A + (size_t)cur.pm * tstep + (size_t)cur.kofs * 2; const char* cB = (const char*)g.Bt + (size_t)cur.pn * tstep + (size_t)cur.kofs * 2;
    S.a_ready(cur);
    if constexpr (SP2) {
        PG8_STAGE(PG8_SB(0, 0), cB, voffB); PG8_STAGE(PG8_SB(0, 1), cB + hstep, voffB); PG8_STAGE(PG8_SA(0, 0), cA, voffA); PG8_STAGE(PG8_SA(0, 1), cA + hstep, voffA);
        if (wr == 1) PG8_BAR;
        PG8_WAIT_V(2); PG8_BAR;
        PG8_STAGE(PG8_SB(1, 0), cB + kstep, voffB); PG8_STAGE(PG8_SA(1, 0), cA + kstep, voffA); PG8_STAGE(PG8_SB(1, 1), cB + hstep + kstep, voffB);
        PG8_WAIT_V(6); PG8_BAR;
    } else {
        PG8_STAGE(PG8_SB(0, 0), cB, voffB); PG8_STAGE(PG8_SA(0, 0), cA, voffA); PG8_STAGE(PG8_SB(0, 1), cB + hstep, voffB); PG8_STAGE(PG8_SA(0, 1), cA + hstep, voffA);
        if (wr == 1) PG8_BAR;
        PG8_WAIT_V(4); PG8_BAR;
        PG8_STAGE(PG8_SB(1, 0), cB + kstep, voffB); PG8_STAGE(PG8_SA(1, 0), cA + kstep, voffA); PG8_STAGE(PG8_SB(1, 1), cB + hstep + kstep, voffB);
        PG8_WAIT_V(6); PG8_BAR;
    }
    for (;;) {
        const bool has_next = S.next(ui + 1, nxt);
        const char* nA = has_next ? (const char*)g.A + (size_t)nxt.pm * tstep + (size_t)nxt.kofs * 2 : cA; const char* nB = has_next ? (const char*)g.Bt + (size_t)nxt.pn * tstep + (size_t)nxt.kofs * 2 : cB;
        const int nt = cur.nt;
        for (int t = 0; t < nt; t += 2) {
            const bool last = (t == nt - 2);
            const char* a1 = cA + (size_t)(t + 1) * kstep;
            const char* a2 = last ? nA : cA + (size_t)(t + 2) * kstep; const char* b2 = last ? nB : cB + (size_t)(t + 2) * kstep;
            const char* a3 = a2 + kstep; const char* b3 = b2 + kstep;
            if (last && has_next) S.a_ready(nxt);
            if constexpr (SP2) {
            PG8_LDB(B0, 0, 0); PG8_LDB(B1, 0, 1); PG8_SCHED; PG8_LDA(At, 0, 0); PG8_STAGE(PG8_SA(1, 1), a1 + hstep, voffA);
            PG8_WAIT_V(8); PG8_WAIT_L(0); PG8_BAR; PG8_MMA(0, 0, At, B0); PG8_MMA(0, 1, At, B1); PG8_BAR; PG8_SCHED;
            PG8_LDA(At, 0, 1); PG8_STAGE(PG8_SB(0, 0), b2, voffB); PG8_STAGE(PG8_SB(0, 1), b2 + hstep, voffB); PG8_STAGE(PG8_SA(0, 0), a2, voffA);
            PG8_WAIT_V(8); PG8_WAIT_L(0); PG8_BAR; PG8_MMA(1, 0, At, B0); PG8_MMA(1, 1, At, B1); PG8_BAR; PG8_SCHED;
            PG8_LDB(B0, 1, 0); PG8_LDB(B1, 1, 1); PG8_SCHED; PG8_LDA(At, 1, 0); PG8_STAGE(PG8_SA(0, 1), a2 + hstep, voffA);
            PG8_WAIT_V(8); PG8_WAIT_L(0); PG8_BAR; PG8_MMA(0, 0, At, B0); PG8_MMA(0, 1, At, B1); PG8_BAR; PG8_SCHED;
            PG8_LDA(At, 1, 1); PG8_STAGE(PG8_SB(1, 0), b3, voffB); PG8_STAGE(PG8_SB(1, 1), b3 + hstep, voffB); PG8_STAGE(PG8_SA(1, 0), a3, voffA);
            PG8_WAIT_V(8); PG8_WAIT_L(0); PG8_BAR; PG8_MMA(1, 0, At, B0); PG8_MMA(1, 1, At, B1); PG8_BAR; PG8_SCHED;
            } else {
            PG8_LDB(B0, 0, 0); PG8_SCHED; PG8_LDA(At, 0, 0); PG8_STAGE(PG8_SA(1, 1), a1 + hstep, voffA);
            PG8_WAIT_L(8); PG8_BAR; PG8_WAIT_L(0); PG8_MMA(0, 0, At, B0); PG8_BAR; PG8_SCHED;
            PG8_LDB(B1, 0, 1); PG8_STAGE(PG8_SB(0, 0), b2, voffB);
            PG8_BAR; PG8_WAIT_L(0); PG8_MMA(0, 1, At, B1); PG8_BAR;
            PG8_LDA(At, 0, 1); PG8_STAGE(PG8_SA(0, 0), a2, voffA);
            PG8_BAR; PG8_WAIT_L(0); PG8_MMA(1, 0, At, B0); PG8_BAR; PG8_SCHED;
            PG8_STAGE(PG8_SB(0, 1), b2 + hstep, voffB);
            PG8_WAIT_V(6); PG8_BAR; PG8_MMA(1, 1, At, B1); PG8_BAR;
            PG8_LDB(B0, 1, 0); PG8_SCHED; PG8_LDA(At, 1, 0); PG8_STAGE(PG8_SA(0, 1), a2 + hstep, voffA);
            PG8_WAIT_L(8); PG8_BAR; PG8_WAIT_L(0); PG8_MMA(0, 0, At, B0); PG8_BAR; PG8_SCHED;
            PG8_LDB(B1, 1, 1); PG8_STAGE(PG8_SB(1, 0), b3, voffB);
            PG8_BAR; PG8_WAIT_L(0); PG8_MMA(0, 1, At, B1); PG8_BAR;
            PG8_LDA(At, 1, 1); PG8_STAGE(PG8_SA(1, 0), a3, voffA);
            PG8_BAR; PG8_WAIT_L(0); PG8_MMA(1, 0, At, B0); PG8_BAR; PG8_SCHED;
            PG8_STAGE(PG8_SB(1, 1), b3 + hstep, voffB);
            PG8_WAIT_V(6); PG8_BAR; PG8_MMA(1, 1, At, B1); PG8_BAR;
            }
        }
        if constexpr (ALIGN_EPI) { if (wr == 0) PG8_BAR; }
        if constexpr (!Epi::AFTER_DRAIN) { E(acc, cur, wr, wc, fr, fq); S.done(cur); }
        if (!has_next) break;
#pragma unroll
        for (int a = 0; a < 2; ++a)
#pragma unroll
            for (int b = 0; b < 2; ++b)
#pragma unroll
                for (int m = 0; m < 4; ++m)
#pragma unroll
                    for (int n = 0; n < 2; ++n) acc[a][b][m][n] = (f32x4){0.f, 0.f, 0.f, 0.f};
        cur = nxt; cA = nA; cB = nB; ++ui;
        if constexpr (ALIGN_EPI) { if (wr == 1) PG8_BAR; }
    }
    PG8_WAIT_V(0);
    if constexpr (!ALIGN_EPI) { if (wr == 0) PG8_BAR; }
    PG8_BAR;
    if constexpr (Epi::AFTER_DRAIN) { E.fused(acc, cur, wr, wc, fr, fq, lds, wid, lane); S.done(cur); }
#undef PG8_SA
#undef PG8_SB
#undef PG8_STAGE
#undef PG8_LDA
#undef PG8_LDB
#undef PG8_MMA
#undef PG8_WAIT_V
#undef PG8_WAIT_L
#undef PG8_BAR
#undef PG8_SCHED
}
}
#define LAS __attribute__((address_space(3)))
typedef unsigned short bf16_t;
using pg8::f32x4; using pg8::u32x4; using pg8::bf16x8;
typedef short s16x4 __attribute__((ext_vector_type(4)));
typedef unsigned u32x2 __attribute__((ext_vector_type(2)));

constexpr int DM = 1024, NBATCH = 8, SEQ = 2048, DBATCH = 128, DSEQ = 4;
constexpr int MP = NBATCH * SEQ, MS = DBATCH * DSEQ, MT = MP + MS;
constexpr int INC = 5120, DFF = 4096;
constexpr int C_QA = 0, C_KA = 512, C_VA = 640, C_QB = 768, C_KB = 1536, C_VB = 2304, C_GA = 3072, C_GB = 4096;
constexpr float RMS_EPS = 1e-6f, LOG2E = 1.4426950408889634f, LN2 = 0.6931471805599453f;
constexpr float SC2 = 0.125f * LOG2E;

constexpr size_t O_Y = 0;
constexpr size_t O_NAP = (size_t)MT * DM;
constexpr size_t O_NAS = O_NAP + (size_t)NBATCH * 128 * 256;
constexpr size_t O_NB1P = O_NAS + (size_t)DBATCH * 128 * 256;
constexpr size_t O_NB1S = O_NB1P + (size_t)NBATCH * 128 * 512;
constexpr size_t O_NB2P = O_NB1S + (size_t)DBATCH * 128 * 512;
constexpr size_t O_NB2S = O_NB2P + (size_t)NBATCH * 512 * 512;
constexpr size_t O_NB3P = O_NB2S + (size_t)DBATCH * 512 * 512;
constexpr size_t O_NB3S = O_NB3P + (size_t)NBATCH * 2048 * 512;
constexpr size_t O_NCP = O_NB3S + (size_t)DBATCH * 2048 * 512;
constexpr size_t O_NCS = O_NCP + (size_t)NBATCH * 2 * DFF;
constexpr size_t O_END = O_NCS + (size_t)DBATCH * 2 * DFF;

constexpr size_t WS_WIN = 0;
constexpr size_t WS_WA = WS_WIN + (size_t)INC * DM * 2;
constexpr size_t WS_WB = WS_WA + (size_t)DM * 512 * 2;
constexpr size_t WS_WOUT = WS_WB + (size_t)DM * 256 * 2;
constexpr size_t WS_WUP = WS_WOUT + (size_t)DM * DM * 2;
constexpr size_t WS_WDN = WS_WUP + (size_t)2 * DFF * DM * 2;
constexpr size_t WS_H = WS_WDN + (size_t)DM * DFF * 2;
constexpr size_t WS_QKVG = WS_H + (size_t)MT * DM * 2;
constexpr size_t WS_OA = WS_QKVG + (size_t)MT * INC * 2;
constexpr size_t WS_OB = WS_OA + (size_t)MT * 512 * 2;
constexpr size_t WS_OG = WS_OB + (size_t)MT * 256 * 2;
constexpr size_t WS_LSE = WS_OG + (size_t)3 * MP * 256 * 4;
constexpr size_t WS_T1 = WS_LSE + (size_t)3 * MP * 4 * 4;
constexpr size_t WS_X1 = WS_T1 + (size_t)MT * DM * 4;
constexpr size_t WS_AG = WS_X1 + (size_t)MT * DM * 4;
constexpr size_t WS_U = WS_AG + (size_t)MT * 2 * DFF * 2;
constexpr size_t WS_PART = WS_U + (size_t)MT * DFF * 2;
constexpr size_t WS_CTL = WS_PART + (size_t)16 * MS * DM * 4;
constexpr size_t WS_BAR = WS_CTL + 4096;
constexpr size_t WS_END = WS_BAR + 2 * 16384;

#ifndef NCW
#define NCW 16
#endif
#define NWK ((int)gridDim.x - NCW)
struct Params {
    const float *x_prompt, *x_sample, *cache_a, *cache_b1, *cache_b2, *cache_b3, *state_conv, *w_in, *sinks_a, *w_a, *w_b, *w_out,
        *g_mix_pre, *g_mix_post, *g_ffn_pre, *g_ffn_post, *w_up, *conv_w, *conv_b, *w_down;
    float* out; unsigned char* ws; int ph_lo, ph_hi, bar_sel, pad_;
};

__device__ __forceinline__ float bf2f(unsigned short h) { return __uint_as_float((unsigned)h << 16); }
__device__ __forceinline__ unsigned pk2(float lo, float hi) { return pg8::cvt_pk_bf16(lo, hi); }
__device__ __forceinline__ float bflo(unsigned w) { return __uint_as_float(w << 16); }
__device__ __forceinline__ float bfhi(unsigned w) { return __uint_as_float(w & 0xffff0000u); }
__device__ __forceinline__ float wave_sum(float v) {
#pragma unroll
    for (int o = 1; o < 64; o <<= 1) v += __shfl_xor(v, o);
    return v;
}
__device__ __forceinline__ float sigmoidf_(float x) { return 1.0f / (1.0f + __builtin_amdgcn_exp2f(-x * LOG2E)); }
__device__ __forceinline__ float ex2(float x) { return __builtin_amdgcn_exp2f(x); }

#define EPI_LOOP_BEGIN \
    const int row0 = u.pm * 256 + wr * 64 + fr, col0 = u.pn * 256 + wc * 32 + 8 * fq; \
    _Pragma("unroll") for (int ai = 0; ai < 2; ++ai) _Pragma("unroll") for (int m = 0; m < 4; ++m) { const size_t row = (size_t)(row0 + ai * 128 + m * 16); \
    _Pragma("unroll") for (int bj = 0; bj < 2; ++bj) { const int col = col0 + bj * 128; f32x4 v0 = acc[ai][bj][m][0], v1 = acc[ai][bj][m][1];
#define EPI_LOOP_END asm volatile("" ::: "memory"); } }

struct EpiStoreBf16 {
    static constexpr bool PERM = true, AFTER_DRAIN = false; bf16_t* O; int ldc;
    __device__ __forceinline__ void operator()(const f32x4 (&acc)[2][2][4][2], const pg8::Unit& u, int wr, int wc, int fr, int fq) const {
        EPI_LOOP_BEGIN
            u32x4 w; w.x = pk2(v0[0], v0[1]); w.y = pk2(v0[2], v0[3]); w.z = pk2(v1[0], v1[1]); w.w = pk2(v1[2], v1[3]);
            *(u32x4*)(O + row * ldc + col) = w;
        EPI_LOOP_END
    }
};
struct EpiStoreQkvg {
    static constexpr bool PERM = true, AFTER_DRAIN = false; bf16_t* O;
    __device__ __forceinline__ void operator()(const f32x4 (&acc)[2][2][4][2], const pg8::Unit& u, int wr, int wc, int fr, int fq) const {
        const bool gate = u.pn * 256 >= C_GA;
        EPI_LOOP_BEGIN
            if (gate) { v0[0] = sigmoidf_(v0[0]); v0[1] = sigmoidf_(v0[1]); v0[2] = sigmoidf_(v0[2]); v0[3] = sigmoidf_(v0[3]); v1[0] = sigmoidf_(v1[0]); v1[1] = sigmoidf_(v1[1]); v1[2] = sigmoidf_(v1[2]); v1[3] = sigmoidf_(v1[3]); }
            u32x4 w; w.x = pk2(v0[0], v0[1]); w.y = pk2(v0[2], v0[3]); w.z = pk2(v1[0], v1[1]); w.w = pk2(v1[2], v1[3]);
            *(u32x4*)(O + row * INC + col) = w;
        EPI_LOOP_END
    }
};
struct EpiStoreF32 {
    static constexpr bool PERM = true, AFTER_DRAIN = false; float* O; int ldc;
    __device__ __forceinline__ void operator()(const f32x4 (&acc)[2][2][4][2], const pg8::Unit& u, int wr, int wc, int fr, int fq) const {
        EPI_LOOP_BEGIN
            *(f32x4*)(O + row * ldc + col) = v0; *(f32x4*)(O + row * ldc + col + 4) = v1;
        EPI_LOOP_END
    }
};
struct EpiGateAB {
    static constexpr bool PERM = true, AFTER_DRAIN = false; bf16_t* T1; const bf16_t* QKVG; bf16_t* O;
    __device__ __forceinline__ void operator()(const f32x4 (&acc)[2][2][4][2], const pg8::Unit& u, int wr, int wc, int fr, int fq) const {
        if (u.kofs == 0) {
            EPI_LOOP_BEGIN
                const u32x4 g = *(const u32x4*)(QKVG + row * INC + C_GA + col);
                u32x4 w; w.x = pk2(v0[0] * bflo(g.x), v0[1] * bfhi(g.x)); w.y = pk2(v0[2] * bflo(g.y), v0[3] * bfhi(g.y)); w.z = pk2(v1[0] * bflo(g.z), v1[1] * bfhi(g.z)); w.w = pk2(v1[2] * bflo(g.w), v1[3] * bfhi(g.w));
                *(u32x4*)(T1 + row * DM + col) = w;
            EPI_LOOP_END
        } else {
            EPI_LOOP_BEGIN
                const u32x4 g = *(const u32x4*)(QKVG + row * INC + C_GB + col);
                const u32x4 t = *(const u32x4*)(T1 + row * DM + col);
                u32x4 w; w.x = pk2(bflo(t.x) + v0[0] * bflo(g.x), bfhi(t.x) + v0[1] * bfhi(g.x)); w.y = pk2(bflo(t.y) + v0[2] * bflo(g.y), bfhi(t.y) + v0[3] * bfhi(g.y));
                w.z = pk2(bflo(t.z) + v1[0] * bflo(g.z), bfhi(t.z) + v1[1] * bfhi(g.z)); w.w = pk2(bflo(t.w) + v1[2] * bflo(g.w), bfhi(t.w) + v1[3] * bfhi(g.w));
                *(u32x4*)(O + row * DM + col) = w;
            EPI_LOOP_END
        }
    }
};
struct PairOrder {
    pg8::StaticOrder so;
    __device__ void init(int G_, int c_) { so.init(MT, DM, G_, c_); so.ntf = 0; }
    __device__ bool next(int i, pg8::Unit& u) const { if (!so.next(i >> 1, u)) return false; if (i & 1) { u.kofs = 512; u.nt = 4; } else { u.kofs = 0; u.nt = 8; } return true; }
    __device__ __forceinline__ void a_ready(const pg8::Unit&) const {}
    __device__ __forceinline__ void done(const pg8::Unit&) const {}
};

__device__ __forceinline__ float dpp_ror1(float x) { return __builtin_bit_cast(float, __builtin_amdgcn_update_dpp(0, __builtin_bit_cast(int, x), 0x121, 0xf, 0xf, false)); }
__device__ __forceinline__ float dpp_ror2(float x) { return __builtin_bit_cast(float, __builtin_amdgcn_update_dpp(0, __builtin_bit_cast(int, x), 0x122, 0xf, 0xf, false)); }
__device__ __forceinline__ float gelu_tanh_f(float x) {
    const float t = 0.7978845608028654f * (x + 0.044715f * x * x * x);
    const float e = ex2(2.0f * LOG2E * t);
    return 0.5f * x * (2.0f - 2.0f / (1.0f + e));
}
constexpr int LDS_HALO_OFF = pg8::STAGE_BYTES + 16;
struct EpiConvGelu {
    static constexpr bool PERM = true, AFTER_DRAIN = false;
    bf16_t* U; bf16_t* AG; const float* conv_w; const float* conv_b; LAS float* hal;
    __device__ __forceinline__ void store_raw(const f32x4 (&acc)[2][2][4][2], int ai, int m, size_t row, int f0) const {
#pragma unroll
        for (int bj = 0; bj < 2; ++bj) { const f32x4 v0 = acc[ai][bj][m][0], v1 = acc[ai][bj][m][1];
            u32x4 w; w.x = pk2(v0[0], v0[1]); w.y = pk2(v0[2], v0[3]); w.z = pk2(v1[0], v1[1]); w.w = pk2(v1[2], v1[3]);
            *(u32x4*)(AG + row * (2 * DFF) + bj * DFF + f0) = w; }
    }
    __device__ __forceinline__ void operator()(const f32x4 (&acc)[2][2][4][2], const pg8::Unit& u, int wr, int wc, int fr, int fq) const {
        const int f0 = u.pn * 128 + wc * 32 + 8 * fq, cl = wc * 32 + 8 * fq;
        const size_t rowt = (size_t)u.pm * 256 + wr * 64 + fr;
        if (u.pm >= MP / 256) {
#pragma unroll
            for (int ai = 0; ai < 2; ++ai)
#pragma unroll
                for (int m = 0; m < 4; ++m) store_raw(acc, ai, m, rowt + ai * 128 + m * 16, f0);
            return;
        }
        if (wr == 0 && fr < 2) store_raw(acc, 0, 0, rowt, f0);
        if (wr == 1 && fr >= 14) store_raw(acc, 1, 3, rowt + 128 + 48, f0);
        if (fr >= 14) {
#pragma unroll
            for (int ai = 0; ai < 2; ++ai)
#pragma unroll
                for (int n = 0; n < 2; ++n) *(LAS f32x4*)(hal + (((2 * ai + wr) * 2 + (fr - 14)) * 128 + cl + 4 * n)) = acc[ai][0][3][n];
        }
        asm volatile("s_waitcnt lgkmcnt(0)" ::: "memory"); __builtin_amdgcn_s_barrier(); asm volatile("" ::: "memory");
        f32x4 w0[2], w1[2], w2[2], cb[2];
#pragma unroll
        for (int n = 0; n < 2; ++n) { w0[n] = *(const f32x4*)(conv_w + f0 + 4 * n); w1[n] = *(const f32x4*)(conv_w + DFF + f0 + 4 * n); w2[n] = *(const f32x4*)(conv_w + 2 * DFF + f0 + 4 * n); cb[n] = *(const f32x4*)(conv_b + f0 + 4 * n); }
#pragma unroll
        for (int ai = 0; ai < 2; ++ai) {
            const int blk = 2 * ai + wr;
            f32x4 h1[2], h2[2];
#pragma unroll
            for (int n = 0; n < 2; ++n) { h1[n] = (f32x4){0.f, 0.f, 0.f, 0.f}; h2[n] = h1[n];
                if (blk >= 1 && fr < 2) { h1[n] = *(const LAS f32x4*)(hal + (((blk - 1) * 2 + 1) * 128 + cl + 4 * n)); h2[n] = *(const LAS f32x4*)(hal + (((blk - 1) * 2 + 0) * 128 + cl + 4 * n)); } }
            f32x4 uo[4][2];
#pragma unroll
            for (int n = 0; n < 2; ++n)
#pragma unroll
                for (int j = 0; j < 4; ++j) {
                    float r1p = h1[n][j], r2p = (fr == 1) ? h1[n][j] : h2[n][j];
#pragma unroll
                    for (int m = 0; m < 4; ++m) {
                        const float x = acc[ai][0][m][n][j];
                        const float r1 = dpp_ror1(x), r2 = dpp_ror2(x);
                        const float p1 = fr >= 1 ? r1 : r1p, p2 = fr >= 2 ? r2 : r2p;
                        const float cv = cb[n][j] + w0[n][j] * p2 + w1[n][j] * p1 + w2[n][j] * x;
                        uo[m][n][j] = gelu_tanh_f(cv) * acc[ai][1][m][n][j];
                        r1p = r1; r2p = r2;
                    }
                }
#pragma unroll
            for (int m = 0; m < 4; ++m) { u32x4 w; w.x = pk2(uo[m][0][0], uo[m][0][1]); w.y = pk2(uo[m][0][2], uo[m][0][3]); w.z = pk2(uo[m][1][0], uo[m][1][1]); w.w = pk2(uo[m][1][2], uo[m][1][3]);
                *(u32x4*)(U + (rowt + ai * 128 + m * 16) * DFF + f0) = w; }
        }
    }
};

template <class Epi>
__device__ __forceinline__ void run_gemm(LAS unsigned char* lds, const bf16_t* A, const bf16_t* Bt, int M, int N, int K, const Epi& E, int nwork = 0) {
    asm volatile("" : "+s"(K));
    if (nwork <= 0) nwork = (int)gridDim.x;
    if ((int)blockIdx.x >= nwork) return;
    pg8::Gemm g; g.A = A; g.Bt = Bt; g.M = M; g.N = N; g.K = K;
    pg8::StaticOrder S; S.init(M, N, nwork, (int)blockIdx.x); S.ntf = K / pg8::BK;
    pg8::gemm_phase<Epi, pg8::StaticOrder, true, true>(lds, g, S, E);
}

struct SplitOrder {
    pg8::StaticOrder so; int nfull, nsub, ksplit, nts, G, c;
    __device__ void init(int N, int K, int ksplit_, int G_, int c_) { so.init(MP, N, G_, c_); so.ntf = K / pg8::BK; nfull = so.nwg; ksplit = ksplit_; nts = (K / ksplit_) / pg8::BK; nsub = (MS / 256) * (N / 256) * ksplit_; G = G_; c = c_; }
    __device__ bool next(int i, pg8::Unit& u) const {
        const long L = (long)i * G + c;
        if (L < nfull) return so.next(i, u);
        const int sidx = (int)(L - nfull); if (sidx >= nsub) return false;
        const int sl = sidx % ksplit, t = sidx / ksplit, nN = so.nN;
        u.pn = t % nN; u.pm = MP / 256 + t / nN; u.kofs = sl * nts * pg8::BK; u.nt = nts; return true;
    }
    __device__ __forceinline__ void a_ready(const pg8::Unit&) const {}
    __device__ __forceinline__ void done(const pg8::Unit&) const {}
};
struct EpiStoreF32Split {
    static constexpr bool PERM = true, AFTER_DRAIN = false; bf16_t* O; float* PART; int kslice;
    __device__ __forceinline__ void operator()(const f32x4 (&acc)[2][2][4][2], const pg8::Unit& u, int wr, int wc, int fr, int fq) const {
        if (u.pm >= MP / 256) {
            float* base = PART + ((ptrdiff_t)(u.kofs / kslice) * MS - (ptrdiff_t)MP) * DM;
            EPI_LOOP_BEGIN
                *(f32x4*)(base + row * DM + col) = v0; *(f32x4*)(base + row * DM + col + 4) = v1;
            EPI_LOOP_END
        } else {
            EPI_LOOP_BEGIN
                u32x4 w; w.x = pk2(v0[0], v0[1]); w.y = pk2(v0[2], v0[3]); w.z = pk2(v1[0], v1[1]); w.w = pk2(v1[2], v1[3]);
                *(u32x4*)(O + row * DM + col) = w;
            EPI_LOOP_END
        }
    }
};
template <class Epi>
__device__ __forceinline__ void run_gemm_split(LAS unsigned char* lds, const bf16_t* A, const bf16_t* Bt, int N, int K, int ksplit, const Epi& E) {
    asm volatile("" : "+s"(K));
    pg8::Gemm g; g.A = A; g.Bt = Bt; g.M = MT; g.N = N; g.K = K;
    SplitOrder S; S.init(N, K, ksplit, (int)gridDim.x, (int)blockIdx.x);
    pg8::gemm_phase<Epi, SplitOrder, true, true>(lds, g, S, E);
}

template <bool UPMAP = false>
__device__ __forceinline__ void transpose_item(const float* W, int K, int N, bf16_t* WT, LAS float* scr, int item, int lane, int ldw = 0, int koff = 0) {
    if (ldw == 0) ldw = K;
    const int nblk = N / 32, kb = item / nblk, nb = item % nblk, k0 = 64 * kb, n0 = 32 * nb;
#pragma unroll 8
    for (int i = 0; i < 32; ++i) { const int kk = 2 * i + (lane >> 5); scr[kk * 33 + (lane & 31)] = W[(size_t)(k0 + kk) * N + n0 + (lane & 31)]; }
    asm volatile("s_waitcnt lgkmcnt(0)" ::: "memory");
    const int c = lane & 7;
#pragma unroll
    for (int j = 0; j < 4; ++j) { const int n = (lane >> 3) + 8 * j; const LAS float* s = scr + (8 * c) * 33 + n;
        u32x4 o; o.x = pk2(s[0 * 33], s[1 * 33]); o.y = pk2(s[2 * 33], s[3 * 33]); o.z = pk2(s[4 * 33], s[5 * 33]); o.w = pk2(s[6 * 33], s[7 * 33]);
        int drow = n0 + n;
        if (UPMAP) { const int f = drow & (DFF - 1), isg = drow >> 12; drow = 256 * (f >> 7) + 128 * isg + (f & 127); }
        *(u32x4*)(WT + (size_t)drow * ldw + koff + k0 + 8 * c) = o; }
    asm volatile("s_waitcnt lgkmcnt(0)" ::: "memory");
}

template <unsigned N4, unsigned SKIP4>
__device__ __forceinline__ void copy_unit(const float* src, float* dst, unsigned unit, int lane) {
    const f32x4* s = (const f32x4*)src; f32x4* d = (f32x4*)dst;
    f32x4 v[16];
#pragma unroll
    for (int k = 0; k < 16; ++k) { const unsigned idx = unit * 1024u + (unsigned)lane + 64u * k; const unsigned b = idx / N4, o = idx - b * N4;
        v[k] = __builtin_nontemporal_load(s + (size_t)b * (N4 + SKIP4) + o + SKIP4); }
#pragma unroll
    for (int k = 0; k < 16; ++k) { const unsigned idx = unit * 1024u + (unsigned)lane + 64u * k; const unsigned b = idx / N4, o = idx - b * N4;
        __builtin_nontemporal_store(v[k], d + (size_t)b * (N4 + SKIP4) + o); }
}
constexpr unsigned CU_B3 = 32704, CU_B2 = 8128, CU_B1 = 1984, CU_A = 992, CH_ALL = CU_B3 + CU_B2 + CU_B1 + CU_A;
__device__ __forceinline__ void copy_any_unit(const Params& p, unsigned ch, int lane) {
    if (ch < CU_B3) { copy_unit<2044u * 128u, 4u * 128u>(p.cache_b3, p.out + O_NB3S, ch, lane); return; } ch -= CU_B3;
    if (ch < CU_B2) { copy_unit<508u * 128u, 4u * 128u>(p.cache_b2, p.out + O_NB2S, ch, lane); return; } ch -= CU_B2;
    if (ch < CU_B1) { copy_unit<124u * 128u, 4u * 128u>(p.cache_b1, p.out + O_NB1S, ch, lane); return; } ch -= CU_B1;
    if (ch < CU_A) copy_unit<124u * 64u, 4u * 64u>(p.cache_a, p.out + O_NAS, ch, lane);
}
__device__ __forceinline__ void copy_dedicated(const Params& p, int ph, unsigned target) {
    unsigned* ctl = (unsigned*)(p.ws + WS_CTL);
    const int lane = threadIdx.x & 63;
    for (;;) {
        unsigned u = 0xffffffffu;
        if (lane == 0) { if (__hip_atomic_load(ctl + 16 + 16 * ph, __ATOMIC_RELAXED, __HIP_MEMORY_SCOPE_AGENT) < target) u = __hip_atomic_fetch_add(ctl, 1u, __ATOMIC_RELAXED, __HIP_MEMORY_SCOPE_AGENT); }
        u = (unsigned)__builtin_amdgcn_readfirstlane((int)u);
        if (u >= CH_ALL) break;
        copy_any_unit(p, u, lane);
    }
}
__device__ __forceinline__ void signal_done(const Params& p, int ph) {
    __syncthreads();
    if (threadIdx.x == 0) __hip_atomic_fetch_add((unsigned*)(p.ws + WS_CTL) + 16 + 16 * ph, 1u, __ATOMIC_RELAXED, __HIP_MEMORY_SCOPE_AGENT);
}

constexpr int I_IN = 16 * 160, I_A = 8 * 32, I_B = 4 * 32, I_OUT = 16 * 32, I_UP = 16 * 256, I_DN = 64 * 32;
constexpr unsigned T_ITEMS = I_A + I_B + I_OUT + I_UP + I_DN, T_TAKES = T_ITEMS / 8;
__device__ __forceinline__ void deferred_transpose_item(const Params& p, LAS float* scr, int r, int lane) {
    bf16_t* WT_A = (bf16_t*)(p.ws + WS_WA);
    bf16_t* WT_OUT = (bf16_t*)(p.ws + WS_WOUT); bf16_t* WT_UP = (bf16_t*)(p.ws + WS_WUP); bf16_t* WT_DN = (bf16_t*)(p.ws + WS_WDN);
    if (r < I_A) { transpose_item(p.w_a, 512, DM, WT_A, scr, r, lane, 768, 0); return; } r -= I_A;
    if (r < I_B) { transpose_item(p.w_b, 256, DM, WT_A, scr, r, lane, 768, 512); return; } r -= I_B;
    if (r < I_OUT) { transpose_item(p.w_out, DM, DM, WT_OUT, scr, r, lane); return; } r -= I_OUT;
    if (r < I_UP) { transpose_item<true>(p.w_up, DM, 2 * DFF, WT_UP, scr, r, lane); return; } r -= I_UP;
    transpose_item(p.w_down, DFF, DM, WT_DN, scr, r, lane);
}
__device__ __forceinline__ void copy_helper(const Params& p, LAS unsigned char* lds, int ph, unsigned target, bool count_me, int mode = 3) {
    unsigned* ctl = (unsigned*)(p.ws + WS_CTL);
    const int tid = threadIdx.x;
    LAS volatile unsigned* sh = (LAS volatile unsigned*)lds;
    LAS float* scr = (LAS float*)(lds + 1024) + (tid >> 6) * (64 * 33);
    __syncthreads();
    if (tid == 0 && count_me) __hip_atomic_fetch_add(ctl + 16 + 16 * ph, 1u, __ATOMIC_RELAXED, __HIP_MEMORY_SCOPE_AGENT);
    bool t_open = (mode & 1) != 0;
    for (;;) {
        if (tid == 0) {
            unsigned w = 0xffffffffu;
            if (target == 0u || __hip_atomic_load(ctl + 16 + 16 * ph, __ATOMIC_RELAXED, __HIP_MEMORY_SCOPE_AGENT) < target) {
                if (t_open) { const unsigned t = __hip_atomic_fetch_add(ctl + 1, 1u, __ATOMIC_RELAXED, __HIP_MEMORY_SCOPE_AGENT); if (t < T_TAKES) w = 0x80000000u | t; }
                if (w == 0xffffffffu && (mode & 2)) { const unsigned ch = __hip_atomic_fetch_add(ctl, 8u, __ATOMIC_RELAXED, __HIP_MEMORY_SCOPE_AGENT); if (ch < CH_ALL) w = ch; }
            }
            sh[0] = w;
        }
        __syncthreads();
        const unsigned w = sh[0];
        __syncthreads();
        if (w == 0xffffffffu) break;
        if (w & 0x80000000u) deferred_transpose_item(p, scr, (int)((w & 0x7fffffffu) * 8u) + (tid >> 6), tid & 63);
        else { t_open = false; copy_any_unit(p, w + (unsigned)(tid >> 6), tid & 63); }
    }
}

__device__ __forceinline__ void phase_prologue(const Params& p, LAS unsigned char* lds) {
    const int tid = threadIdx.x, lane = tid & 63, wid = tid >> 6;
    const int gw = blockIdx.x * 8 + wid, nw = NWK * 8;
    LAS float* scr = (LAS float*)lds + wid * (64 * 33);
    bf16_t* WT_IN = (bf16_t*)(p.ws + WS_WIN);
    for (int it = gw; it < I_IN; it += nw) transpose_item(p.w_in, DM, INC, WT_IN, scr, it, lane);
    bf16_t* H = (bf16_t*)(p.ws + WS_H);
    for (int row = gw; row < MT; row += nw) {
        const float* xr = row < MP ? p.x_prompt + (size_t)row * DM : p.x_sample + (size_t)(row - MP) * DM;
        f32x4 v[4]; float s = 0.f;
#pragma unroll
        for (int j = 0; j < 4; ++j) { v[j] = ((const f32x4*)xr)[lane + 64 * j]; s += (v[j][0] * v[j][0] + v[j][1] * v[j][1]) + (v[j][2] * v[j][2] + v[j][3] * v[j][3]); }
        const float r = rsqrtf(wave_sum(s) * (1.0f / DM) + RMS_EPS);
#pragma unroll
        for (int j = 0; j < 4; ++j) { const f32x4 g = ((const f32x4*)p.g_mix_pre)[lane + 64 * j];
            u32x2 o; o.x = pk2(v[j][0] * r * g[0], v[j][1] * r * g[1]); o.y = pk2(v[j][2] * r * g[2], v[j][3] * r * g[3]);
            *(u32x2*)(H + (size_t)row * DM + (lane + 64 * j) * 4) = o; }
    }
}
#define XB_TMO      128
#define XB_XCNT(j)  (256  + 64 * (j))
#define XB_XSUB(j)  (1280 + 64 * (j))
#define XB_XGEN(j)  (2304 + 64 * (j))
#define XB_TOP      3328
#define XB_TOPGEN   3392
#define XCD_BAR_WORDS 3456
#define XB_SPIN_CAP (1u << 18)

__device__ __forceinline__ unsigned xb_ld(unsigned* p)              { return __hip_atomic_load(p, __ATOMIC_RELAXED, __HIP_MEMORY_SCOPE_AGENT); }
__device__ __forceinline__ unsigned xb_add(unsigned* p, unsigned v) { return __hip_atomic_fetch_add(p, v, __ATOMIC_RELAXED, __HIP_MEMORY_SCOPE_AGENT); }
__device__ __forceinline__ unsigned xb_xcc_id() { return (unsigned)__builtin_amdgcn_s_getreg((3 << 11) | 20) & 0xFu; }
#define XB_SPIN(cond, bar) do { unsigned _sp = 0; while (cond) { __builtin_amdgcn_s_sleep(1); \
    if ((++_sp & 255u) == 0u) { if (xb_ld(&(bar)[XB_TMO])) break; if (_sp > XB_SPIN_CAP) { atomicAdd(&(bar)[XB_TMO], 1u); break; } } } } while (0)

struct XcdBarrier {
    unsigned* bar; unsigned x;
    volatile LAS unsigned* st;
};

__device__ __forceinline__ XcdBarrier xcd_barrier_post(unsigned* bar, volatile LAS unsigned* st) {
    XcdBarrier b; b.bar = bar; b.x = xb_xcc_id(); b.st = st;
    if (threadIdx.x == 0) (void)xb_add(&bar[XB_XCNT(b.x)], 1u);
    return b;
}
__device__ __forceinline__ void xcd_barrier_complete(unsigned* bar, unsigned x, unsigned& nloc, unsigned& nx) {
    const unsigned G = gridDim.x * gridDim.y * gridDim.z;
    unsigned sum, cnt, mine, sp = 0u;
    for (;;) {
        sum = 0u; cnt = 0u; mine = 0u;
#pragma unroll
        for (unsigned j = 0; j < 16; ++j) { const unsigned c = xb_ld(&bar[XB_XCNT(j)]); sum += c; cnt += (c > 0u) ? 1u : 0u; mine = (j == x) ? c : mine; }
        if (sum == G) break;
        __builtin_amdgcn_s_sleep(1);
        if ((++sp & 255u) == 0u) { if (xb_ld(&bar[XB_TMO])) break; if (sp > XB_SPIN_CAP) { atomicAdd(&bar[XB_TMO], 1u); break; } }
    }
    nloc = mine > 0u ? mine : 1u; nx = cnt > 0u ? cnt : 1u;
}

__device__ __forceinline__ void xcd_barrier(const XcdBarrier& b) {
    asm volatile("s_waitcnt vmcnt(0)" ::: "memory");
    __syncthreads();
    if (threadIdx.x == 0) {
        unsigned* bar = b.bar;
        __builtin_amdgcn_s_waitcnt(0);
        unsigned nloc = b.st[0], nx = b.st[1];
        if (nloc == 0u) { xcd_barrier_complete(bar, b.x, nloc, nx); b.st[0] = nloc; b.st[1] = nx; }
        const unsigned old = xb_add(&bar[XB_XSUB(b.x)], 1u);
        const unsigned gen = old / nloc;
        if (old + 1u == (gen + 1u) * nloc) {
            __builtin_amdgcn_fence(__ATOMIC_RELEASE, "agent");
            asm volatile("s_waitcnt vmcnt(0)" ::: "memory");
            const unsigned og = xb_add(&bar[XB_TOP], 1u);
            const unsigned tg = og / nx;
            if (og + 1u == (tg + 1u) * nx) xb_add(&bar[XB_TOPGEN], 1u);
            else XB_SPIN(xb_ld(&bar[XB_TOPGEN]) == tg, bar);
            __builtin_amdgcn_fence(__ATOMIC_ACQUIRE, "agent");
            xb_add(&bar[XB_XGEN(b.x)], 1u);
            asm volatile("s_waitcnt vmcnt(0)" ::: "memory");
        } else {
            XB_SPIN(xb_ld(&bar[XB_XGEN(b.x)]) == gen, bar);
            __builtin_amdgcn_fence(__ATOMIC_ACQUIRE, "agent");
            asm volatile("s_waitcnt vmcnt(0)" ::: "memory");
        }
    }
    __syncthreads();
}

constexpr int KROWB = 144;
constexpr int KV_ROWS = 272;
constexpr int LDS_V_OFF = KV_ROWS * KROWB;
__device__ __forceinline__ s16x4 tr_read(unsigned lds_addr) { s16x4 r; asm volatile("ds_read_b64_tr_b16 %0, %1\n\ts_waitcnt lgkmcnt(0)" : "=&v"(r) : "v"(lds_addr) : "memory"); return r; }

__device__ __forceinline__ void attn_prompt(const Params& p, LAS unsigned char* lds) {
    const bf16_t* QKVG = (const bf16_t*)(p.ws + WS_QKVG);
    bf16_t* OA = (bf16_t*)(p.ws + WS_OA);
    float* OG = (float*)(p.ws + WS_OG); float* LSE = (float*)(p.ws + WS_LSE);
    const int tid = threadIdx.x, lane = tid & 63, w = tid >> 6, fr = lane & 15, fq = lane >> 4;
    const unsigned ldsK = (unsigned)(uintptr_t)lds, ldsV = ldsK + LDS_V_OFF;
    if (tid < 128) { const int row = 256 + (tid >> 3), ch = tid & 7; const u32x4 z = {0u, 0u, 0u, 0u};
        *(LAS u32x4*)(lds + row * KROWB + ch * 16) = z; *(LAS u32x4*)(lds + LDS_V_OFF + row * KROWB + ch * 16) = z; }
    constexpr int N_A = 256, N_B = 1536;
    for (int item = blockIdx.x; item < N_A + N_B; item += NWK) {
        int b, dil, r, nbk, colK, colV, colQ, nheads, maxd, head0, grp = 0, slot = 0; bool isA;
        if (item < N_A) { isA = true; b = item >> 5; const int rem = item & 31; nbk = rem >> 1; const int kvh = rem & 1; dil = 1; r = 0;
            colK = C_KA + kvh * 64; colV = C_VA + kvh * 64; head0 = kvh * 4; colQ = C_QA + head0 * 64; nheads = 4; maxd = 127; }
        else { isA = false; const int idx = item - N_A; grp = idx >> 9; const int rem = idx & 511; b = rem >> 6; const int rem2 = rem & 63; const int sub = rem2 >> 2; slot = rem2 & 3;
            dil = grp == 0 ? 1 : (grp == 1 ? 4 : 16); const int nbpr = 16 / dil; r = sub / nbpr; nbk = sub % nbpr;
            head0 = 4 * grp + slot; colK = C_KB + head0 * 64; colV = C_VB + head0 * 64; colQ = C_QB + head0 * 64; nheads = 1; maxd = 128; }
        __syncthreads();
#pragma unroll
        for (int it = 0; it < 4; ++it) {
            const int idx = tid + 512 * it, row = idx >> 3, ch = idx & 7, sk = 128 * nbk - 128 + row;
            u32x4 kv = {0u, 0u, 0u, 0u}, vv = {0u, 0u, 0u, 0u};
            if (sk >= 0) { const bf16_t* src = QKVG + (size_t)(b * SEQ + r + dil * sk) * INC; kv = *(const u32x4*)(src + colK + ch * 8); vv = *(const u32x4*)(src + colV + ch * 8); }
            *(LAS u32x4*)(lds + row * KROWB + ch * 16) = kv; *(LAS u32x4*)(lds + LDS_V_OFF + row * KROWB + ch * 16) = vv;
        }
        __syncthreads();
        const int sq = 128 * nbk + 16 * w + fr;
        const size_t grow = (size_t)(b * SEQ + r + dil * sq);
        for (int hh = 0; hh < nheads; ++hh) {
            const int head = head0 + hh;
            const float slope = isA ? ex2(-(float)(head + 1)) : ex2(-8.0f * (float)(head + 1) / 12.0f);
            const float slope2 = slope * (float)dil * LOG2E;
            const bf16_t* qp = QKVG + grow * INC + colQ + hh * 64 + fq * 8;
            const bf16x8 Q0 = *(const bf16x8*)qp, Q1 = *(const bf16x8*)(qp + 32);
            f32x4 st[10];
#pragma unroll
            for (int tl = 0; tl < 10; ++tl) {
                const LAS unsigned char* ka = lds + ((w + tl) * 16 + fr) * KROWB + fq * 16;
                const bf16x8 K0 = *(const LAS bf16x8*)ka, K1 = *(const LAS bf16x8*)(ka + 64);
                f32x4 z = {0.f, 0.f, 0.f, 0.f};
                z = __builtin_amdgcn_mfma_f32_16x16x32_bf16(K0, Q0, z, 0, 0, 0);
                st[tl] = __builtin_amdgcn_mfma_f32_16x16x32_bf16(K1, Q1, z, 0, 0, 0);
            }
            float mx = -1e30f;
#pragma unroll
            for (int tl = 0; tl < 10; ++tl)
#pragma unroll
                for (int j = 0; j < 4; ++j) {
                    const int dist = 128 + fr - tl * 16 - fq * 4 - j;
                    const int sk = 128 * nbk - 128 + (w + tl) * 16 + fq * 4 + j;
                    const bool ok = (dist >= 0) && (dist <= maxd) && (sk >= 0);
                    const float s = ok ? st[tl][j] * SC2 - slope2 * (float)dist : -1e30f;
                    st[tl][j] = s; mx = fmaxf(mx, s);
                }
            mx = fmaxf(mx, __shfl_xor(mx, 16)); mx = fmaxf(mx, __shfl_xor(mx, 32));
            float sink2 = -1e30f;
            if (isA) { sink2 = p.sinks_a[head] * LOG2E; mx = fmaxf(mx, sink2); }
            float l = 0.f;
#pragma unroll
            for (int tl = 0; tl < 10; ++tl)
#pragma unroll
                for (int j = 0; j < 4; ++j) { const float e = ex2(st[tl][j] - mx); st[tl][j] = e; l += e; }
            l += __shfl_xor(l, 16); l += __shfl_xor(l, 32);
            if (isA) l += ex2(sink2 - mx);
            f32x4 o[4];
#pragma unroll
            for (int dt = 0; dt < 4; ++dt) o[dt] = (f32x4){0.f, 0.f, 0.f, 0.f};
#pragma unroll
            for (int ks = 0; ks < 5; ++ks) {
                u32x4 pw; pw.x = pk2(st[2 * ks][0], st[2 * ks][1]); pw.y = pk2(st[2 * ks][2], st[2 * ks][3]); pw.z = pk2(st[2 * ks + 1][0], st[2 * ks + 1][1]); pw.w = pk2(st[2 * ks + 1][2], st[2 * ks + 1][3]);
                bf16x8 pf; __builtin_memcpy(&pf, &pw, 16);
#pragma unroll
                for (int dt = 0; dt < 4; ++dt) {
                    const unsigned va = ldsV + (unsigned)(((w + 2 * ks) * 16 + fq * 4 + (fr >> 2)) * KROWB + (dt * 16 + (fr & 3) * 4) * 2);
                    const s16x4 v0 = tr_read(va), v1 = tr_read(va + 16 * KROWB);
                    bf16x8 vf; vf[0] = v0[0]; vf[1] = v0[1]; vf[2] = v0[2]; vf[3] = v0[3]; vf[4] = v1[0]; vf[5] = v1[1]; vf[6] = v1[2]; vf[7] = v1[3];
                    o[dt] = __builtin_amdgcn_mfma_f32_16x16x32_bf16(vf, pf, o[dt], 0, 0, 0);
                }
            }
            const float inv = 1.0f / l;
            if (isA) {
#pragma unroll
                for (int dt = 0; dt < 4; ++dt) { u32x2 ww; ww.x = pk2(o[dt][0] * inv, o[dt][1] * inv); ww.y = pk2(o[dt][2] * inv, o[dt][3] * inv);
                    *(u32x2*)(OA + grow * 768 + head * 64 + dt * 16 + fq * 4) = ww; }
            } else {
                float* og = OG + ((size_t)grp * MP + grow) * 256 + slot * 64 + fq * 4;
#pragma unroll
                for (int dt = 0; dt < 4; ++dt) *(f32x4*)(og + dt * 16) = o[dt] * inv;
                if (fq == 0) LSE[((size_t)grp * MP + grow) * 4 + slot] = (mx + __builtin_amdgcn_logf(l)) * LN2;
            }
        }
    }
}

__device__ __forceinline__ void attn_sample(const Params& p) {
    const bf16_t* QKVG = (const bf16_t*)(p.ws + WS_QKVG);
    bf16_t* OA = (bf16_t*)(p.ws + WS_OA); bf16_t* OB = (bf16_t*)(p.ws + WS_OB);
    const int tid = threadIdx.x, lane = tid & 63, wid = tid >> 6, g4 = lane >> 4, c = lane & 15;
    const int gw = blockIdx.x * 8 + wid, nw = NWK * 8;
    constexpr int N_SA = MS * 8, N_SB = MS * 4;
#pragma nounroll
    for (int item = gw; item < N_SA + N_SB; item += nw) {
        const bool isA = item < N_SA;
        const int it2 = isA ? item : item - N_SA;
        const int tok = isA ? (it2 >> 3) : (it2 >> 2), hs = isA ? (it2 & 7) : (it2 & 3), b = tok >> 2, i = tok & 3;
        const size_t row = (size_t)MP + tok, row0 = (size_t)MP + b * 4;
        float m_ = -1e30f, l_ = 0.f; f32x4 acc = {0.f, 0.f, 0.f, 0.f};
        const int nseg = isA ? 1 : 3;
#pragma nounroll
        for (int g = 0; g < nseg; ++g) {
            const int head = isA ? hs : 4 * g + hs;
            const int win = (isA || g == 0) ? 128 : (g == 1 ? 512 : 2048), dil = (isA || g == 0) ? 1 : (g == 1 ? 4 : 16);
            const int nkeys = isA ? 128 : 129;
            const float* cache = isA ? p.cache_a : (g == 0 ? p.cache_b1 : (g == 1 ? p.cache_b2 : p.cache_b3));
            const int RS = isA ? 256 : 512, VOFF = isA ? 128 : 256;
            const int kvh = isA ? (hs >> 2) : hs;
            const float* cK = cache + (size_t)b * win * RS + kvh * 64 + c * 4;
            const int colQ = isA ? C_QA + head * 64 : C_QB + head * 64, colK = isA ? C_KA + kvh * 64 : C_KB + head * 64, colV = isA ? C_VA + kvh * 64 : C_VB + head * 64;
            const bf16_t* nK = QKVG + row0 * INC + colK + c * 4; const bf16_t* nV = QKVG + row0 * INC + colV + c * 4;
            const u32x2 qa = *(const u32x2*)(QKVG + row * INC + colQ + c * 4);
            const f32x4 q = {bflo(qa.x), bfhi(qa.x), bflo(qa.y), bfhi(qa.y)};
            const float slope2 = (isA ? ex2(-(float)(head + 1)) : ex2(-8.0f * (float)(head + 1) / 12.0f)) * LOG2E;
            const int joff = isA ? 0 : 1;
            if (!isA) {
                const u32x2 ka = *(const u32x2*)(nK + (size_t)i * INC), va = *(const u32x2*)(nV + (size_t)i * INC);
                float s = (q[0] * bflo(ka.x) + q[1] * bfhi(ka.x)) + (q[2] * bflo(ka.y) + q[3] * bfhi(ka.y));
                s += __shfl_xor(s, 1); s += __shfl_xor(s, 2); s += __shfl_xor(s, 4); s += __shfl_xor(s, 8);
                s = (g4 == 0) ? s * SC2 : -1e30f;
                const float mn = fmaxf(m_, s), corr = ex2(m_ - mn), pe = ex2(s - mn);
                const f32x4 vself = {bflo(va.x), bfhi(va.x), bflo(va.y), bfhi(va.y)};
                m_ = mn; l_ = l_ * corr + pe; acc = acc * corr + vself * pe;
            }
#pragma nounroll
            for (int j0 = joff; j0 < nkeys; j0 += 64) {
                f32x4 kk[16], vv[16];
#pragma unroll
                for (int u = 0; u < 16; ++u) {
                    const int jj = j0 + u * 4 + g4; const int f = win + i - jj * dil;
                    kk[u] = (f32x4){0.f, 0.f, 0.f, 0.f}; vv[u] = kk[u];
                    if (jj < nkeys) {
                        if (f >= win) { const u32x2 a = *(const u32x2*)(nK + (size_t)(f - win) * INC), bb = *(const u32x2*)(nV + (size_t)(f - win) * INC);
                            kk[u] = (f32x4){bflo(a.x), bfhi(a.x), bflo(a.y), bfhi(a.y)}; vv[u] = (f32x4){bflo(bb.x), bfhi(bb.x), bflo(bb.y), bfhi(bb.y)}; }
                        else { kk[u] = *(const f32x4*)(cK + (size_t)f * RS); vv[u] = *(const f32x4*)(cK + (size_t)f * RS + VOFF); }
                    }
                }
#pragma unroll
                for (int u = 0; u < 16; ++u) {
                    const int jj = j0 + u * 4 + g4;
                    float s = (q[0] * kk[u][0] + q[1] * kk[u][1]) + (q[2] * kk[u][2] + q[3] * kk[u][3]);
                    s += __shfl_xor(s, 1); s += __shfl_xor(s, 2); s += __shfl_xor(s, 4); s += __shfl_xor(s, 8);
                    s = (jj < nkeys) ? s * SC2 - slope2 * (float)(jj * dil) : -1e30f;
                    const float mn = fmaxf(m_, s), corr = ex2(m_ - mn), pe = ex2(s - mn);
                    m_ = mn; l_ = l_ * corr + pe; acc = acc * corr + vv[u] * pe;
                }
            }
        }
        float M = fmaxf(m_, __shfl_xor(m_, 16)); M = fmaxf(M, __shfl_xor(M, 32));
        float sink2 = -1e30f;
        if (isA) { sink2 = p.sinks_a[hs] * LOG2E; M = fmaxf(M, sink2); }
        const float cf = ex2(m_ - M); float l = l_ * cf; f32x4 a = acc * cf;
        l += __shfl_xor(l, 16); l += __shfl_xor(l, 32);
#pragma unroll
        for (int e = 0; e < 4; ++e) { a[e] += __shfl_xor(a[e], 16); a[e] += __shfl_xor(a[e], 32); }
        if (isA) l += ex2(sink2 - M);
        const float inv = 1.0f / l;
        if (g4 == 0) { u32x2 ww; ww.x = pk2(a[0] * inv, a[1] * inv); ww.y = pk2(a[2] * inv, a[3] * inv);
            bf16_t* o = isA ? OA + row * 768 + hs * 64 + c * 4 : OA + row * 768 + 512 + hs * 64 + c * 4; *(u32x2*)o = ww; }
    }
}

__device__ __forceinline__ void write_new_rows(const bf16_t* QKVG, float* out, int nb, int Wout, int first, int nrows, int src0, int src_per_b, int colK, int colV, int ncols, size_t gtid, size_t gth) {
    const int c8n = ncols / 8; const size_t total = (size_t)nb * nrows * 2 * c8n;
    for (size_t i = gtid; i < total; i += gth) {
        const int c8 = (int)(i % c8n); size_t t = i / c8n; const int kv = (int)(t & 1); t >>= 1; const int r = (int)(t % nrows); const int b = (int)(t / nrows);
        const u32x4 v = *(const u32x4*)(QKVG + (size_t)(src0 + b * src_per_b + r) * INC + (kv ? colV : colK) + c8 * 8);
        float* o = out + (((size_t)b * Wout + first + r) * 2 + kv) * ncols + c8 * 8;
        *(f32x4*)o = (f32x4){bflo(v.x), bfhi(v.x), bflo(v.y), bfhi(v.y)}; *(f32x4*)(o + 4) = (f32x4){bflo(v.z), bfhi(v.z), bflo(v.w), bfhi(v.w)};
    }
}
__device__ __forceinline__ void phase_attention(const Params& p, LAS unsigned char* lds) {
#ifndef NO_AP
    attn_prompt(p, lds);
#ifdef DBL_AP
    attn_prompt(p, lds);
#endif
#endif
#ifndef NO_AS
    attn_sample(p);
#ifdef DBL_AS
    attn_sample(p);
#endif
#endif
    const bf16_t* QKVG = (const bf16_t*)(p.ws + WS_QKVG);
    const size_t gtid = (size_t)blockIdx.x * 512 + threadIdx.x, gth = (size_t)NWK * 512;
    write_new_rows(QKVG, p.out + O_NAP, NBATCH, 128, 0, 128, SEQ - 128, SEQ, C_KA, C_VA, 128, gtid, gth);
    write_new_rows(QKVG, p.out + O_NB1P, NBATCH, 128, 0, 128, SEQ - 128, SEQ, C_KB, C_VB, 256, gtid, gth);
    write_new_rows(QKVG, p.out + O_NB2P, NBATCH, 512, 0, 512, SEQ - 512, SEQ, C_KB + 256, C_VB + 256, 256, gtid, gth);
    write_new_rows(QKVG, p.out + O_NB3P, NBATCH, 2048, 0, 2048, 0, SEQ, C_KB + 512, C_VB + 512, 256, gtid, gth);
    write_new_rows(QKVG, p.out + O_NAS, DBATCH, 128, 124, 4, MP, 4, C_KA, C_VA, 128, gtid, gth);
    write_new_rows(QKVG, p.out + O_NB1S, DBATCH, 128, 124, 4, MP, 4, C_KB, C_VB, 256, gtid, gth);
    write_new_rows(QKVG, p.out + O_NB2S, DBATCH, 512, 508, 4, MP, 4, C_KB + 256, C_VB + 256, 256, gtid, gth);
    write_new_rows(QKVG, p.out + O_NB3S, DBATCH, 2048, 2044, 4, MP, 4, C_KB + 512, C_VB + 512, 256, gtid, gth);
}
__device__ __forceinline__ void phase_combine(const Params& p) {
    const float* OG = (const float*)(p.ws + WS_OG); const float* LSE = (const float*)(p.ws + WS_LSE); bf16_t* OB = (bf16_t*)(p.ws + WS_OA);
    const size_t gtid = (size_t)blockIdx.x * 512 + threadIdx.x, gth = (size_t)NWK * 512;
    for (size_t i = gtid; i < (size_t)MP * 64; i += gth) {
        const size_t row = i >> 6; const int c4 = (int)(i & 63), slot = c4 >> 4;
        const float l0 = LSE[row * 4 + slot], l1 = LSE[((size_t)MP + row) * 4 + slot], l2 = LSE[((size_t)2 * MP + row) * 4 + slot];
        const float mm = fmaxf(l0, fmaxf(l1, l2));
        float w0 = ex2((l0 - mm) * LOG2E), w1 = ex2((l1 - mm) * LOG2E), w2 = ex2((l2 - mm) * LOG2E);
        const float inv = 1.0f / (w0 + w1 + w2); w0 *= inv; w1 *= inv; w2 *= inv;
        const f32x4 a = *(const f32x4*)(OG + row * 256 + c4 * 4), bq = *(const f32x4*)(OG + ((size_t)MP + row) * 256 + c4 * 4), cq = *(const f32x4*)(OG + ((size_t)2 * MP + row) * 256 + c4 * 4);
        const f32x4 o = a * w0 + bq * w1 + cq * w2;
        u32x2 ww; ww.x = pk2(o[0], o[1]); ww.y = pk2(o[2], o[3]);
        *(u32x2*)(OB + row * 768 + 512 + c4 * 4) = ww;
    }
}
constexpr int KS5 = 4, KS9 = 16;
__device__ __forceinline__ void phase_norm_mid(const Params& p) {
    const bf16_t* MIX = (const bf16_t*)(p.ws + WS_T1); const float* PART = (const float*)(p.ws + WS_PART); float* X1 = (float*)(p.ws + WS_X1); bf16_t* H2 = (bf16_t*)(p.ws + WS_H);
    const int lane = threadIdx.x & 63, wid = threadIdx.x >> 6, gw = blockIdx.x * 8 + wid, nw = NWK * 8;
    for (int row = gw; row < MT; row += nw) {
        const float* xr = row < MP ? p.x_prompt + (size_t)row * DM : p.x_sample + (size_t)(row - MP) * DM;
        f32x4 mv[4], xv[4]; float s = 0.f;
#pragma unroll
        for (int j = 0; j < 4; ++j) {
            if (row < MP) { const u32x2 wv = ((const u32x2*)(MIX + (size_t)row * DM))[lane + 64 * j]; mv[j] = (f32x4){bflo(wv.x), bfhi(wv.x), bflo(wv.y), bfhi(wv.y)}; }
            else { mv[j] = (f32x4){0.f, 0.f, 0.f, 0.f};
#pragma unroll
                for (int sl = 0; sl < KS5; ++sl) mv[j] += ((const f32x4*)(PART + ((size_t)sl * MS + (row - MP)) * DM))[lane + 64 * j]; }
            xv[j] = ((const f32x4*)xr)[lane + 64 * j];
            s += (mv[j][0] * mv[j][0] + mv[j][1] * mv[j][1]) + (mv[j][2] * mv[j][2] + mv[j][3] * mv[j][3]); }
        const float r1 = rsqrtf(wave_sum(s) * (1.0f / DM) + RMS_EPS);
        float s2 = 0.f;
#pragma unroll
        for (int j = 0; j < 4; ++j) { const f32x4 g = ((const f32x4*)p.g_mix_post)[lane + 64 * j]; xv[j] = xv[j] + mv[j] * r1 * g;
            s2 += (xv[j][0] * xv[j][0] + xv[j][1] * xv[j][1]) + (xv[j][2] * xv[j][2] + xv[j][3] * xv[j][3]);
            ((f32x4*)(X1 + (size_t)row * DM))[lane + 64 * j] = xv[j]; }
        const float r2 = rsqrtf(wave_sum(s2) * (1.0f / DM) + RMS_EPS);
#pragma unroll
        for (int j = 0; j < 4; ++j) { const f32x4 g = ((const f32x4*)p.g_ffn_pre)[lane + 64 * j];
            u32x2 o; o.x = pk2(xv[j][0] * r2 * g[0], xv[j][1] * r2 * g[1]); o.y = pk2(xv[j][2] * r2 * g[2], xv[j][3] * r2 * g[3]);
            *(u32x2*)(H2 + (size_t)row * DM + (lane + 64 * j) * 4) = o; }
    }
}
__device__ __forceinline__ float gelu_tanh(float x) {
    const float t = 0.7978845608028654f * (x + 0.044715f * x * x * x);
    const float e = ex2(2.0f * LOG2E * t);
    const float th = 1.0f - 2.0f / (1.0f + e);
    return 0.5f * x * (1.0f + th);
}
__device__ __forceinline__ void ld8(const bf16_t* ptr, float (&o)[8]) {
    const u32x4 v = *(const u32x4*)ptr; o[0] = bflo(v.x); o[1] = bfhi(v.x); o[2] = bflo(v.y); o[3] = bfhi(v.y); o[4] = bflo(v.z); o[5] = bfhi(v.z); o[6] = bflo(v.w); o[7] = bfhi(v.w);
}
__device__ __forceinline__ void ld8f(const float* ptr, float (&o)[8]) {
    const f32x4 a = *(const f32x4*)ptr, b = *(const f32x4*)(ptr + 4); o[0] = a[0]; o[1] = a[1]; o[2] = a[2]; o[3] = a[3]; o[4] = b[0]; o[5] = b[1]; o[6] = b[2]; o[7] = b[3];
}
__device__ __forceinline__ void phase_conv(const Params& p) {
    const bf16_t* AG = (const bf16_t*)(p.ws + WS_AG); bf16_t* U = (bf16_t*)(p.ws + WS_U);
    const size_t gtid = (size_t)blockIdx.x * 512 + threadIdx.x, gth = (size_t)NWK * 512;
    for (size_t i = gtid; i < (size_t)NBATCH * 2 * 512; i += gth) {
        const int f0 = (int)(i & 511) * 8, k = (int)(i >> 9) & 1, b = (int)(i >> 10);
        float a2[8]; ld8(AG + (size_t)(b * SEQ + SEQ - 2 + k) * 8192 + f0, a2);
        float* o = p.out + O_NCP + ((size_t)b * 2 + k) * DFF + f0;
        *(f32x4*)o = (f32x4){a2[0], a2[1], a2[2], a2[3]}; *(f32x4*)(o + 4) = (f32x4){a2[4], a2[5], a2[6], a2[7]};
    }
    for (size_t i = gtid; i < (size_t)(MS + 2 * (MP / 256)) * 512; i += gth) {
        const int ri = (int)(i >> 9), f0 = (int)(i & 511) * 8;
        const int row = ri < MS ? MP + ri : ((ri - MS) >> 1) * 256 + ((ri - MS) & 1);
        float a0[8], a1[8], a2[8], g[8], w0[8], w1[8], w2[8], cb[8];
        ld8(AG + (size_t)row * 8192 + f0, a2); ld8(AG + (size_t)row * 8192 + DFF + f0, g);
        ld8f(p.conv_w + f0, w0); ld8f(p.conv_w + DFF + f0, w1); ld8f(p.conv_w + 2 * DFF + f0, w2); ld8f(p.conv_b + f0, cb);
        if (row < MP) {
            const int pos = row & (SEQ - 1);
            if (pos >= 1) ld8(AG + (size_t)(row - 1) * 8192 + f0, a1); else { for (int e = 0; e < 8; ++e) a1[e] = 0.f; }
            if (pos >= 2) ld8(AG + (size_t)(row - 2) * 8192 + f0, a0); else { for (int e = 0; e < 8; ++e) a0[e] = 0.f; }
        } else {
            const int sr = row - MP, b = sr >> 2, pos = sr & 3;
            const float* stc = p.state_conv + (size_t)b * 2 * DFF + f0;
            if (pos >= 1) ld8(AG + (size_t)(row - 1) * 8192 + f0, a1); else ld8f(stc + DFF, a1);
            if (pos >= 2) ld8(AG + (size_t)(row - 2) * 8192 + f0, a0); else ld8f(stc + (size_t)pos * DFF, a0);
            if (pos >= 2) { float* o = p.out + O_NCS + ((size_t)b * 2 + (pos - 2)) * DFF + f0;
                *(f32x4*)o = (f32x4){a2[0], a2[1], a2[2], a2[3]}; *(f32x4*)(o + 4) = (f32x4){a2[4], a2[5], a2[6], a2[7]}; }
        }
        float uo[8];
#pragma unroll
        for (int e = 0; e < 8; ++e) { const float cv = cb[e] + w0[e] * a0[e] + w1[e] * a1[e] + w2[e] * a2[e]; uo[e] = gelu_tanh(cv) * g[e]; }
        u32x4 w; w.x = pk2(uo[0], uo[1]); w.y = pk2(uo[2], uo[3]); w.z = pk2(uo[4], uo[5]); w.w = pk2(uo[6], uo[7]);
        *(u32x4*)(U + (size_t)row * DFF + f0) = w;
    }
}
__device__ __forceinline__ void phase_norm_out(const Params& p) {
    const bf16_t* F = (const bf16_t*)(p.ws + WS_T1); const float* X1 = (const float*)(p.ws + WS_X1); const float* PART = (const float*)(p.ws + WS_PART);
    const int lane = threadIdx.x & 63, wid = threadIdx.x >> 6, gw = blockIdx.x * 8 + wid, nw = NWK * 8;
    for (int row = gw; row < MT; row += nw) {
        f32x4 fv[4]; float s = 0.f;
#pragma unroll
        for (int j = 0; j < 4; ++j) {
            if (row < MP) { const u32x2 wv = ((const u32x2*)(F + (size_t)row * DM))[lane + 64 * j]; fv[j] = (f32x4){bflo(wv.x), bfhi(wv.x), bflo(wv.y), bfhi(wv.y)}; }
            else { fv[j] = (f32x4){0.f, 0.f, 0.f, 0.f};
#pragma unroll
                for (int sl = 0; sl < KS9; ++sl) fv[j] += ((const f32x4*)(PART + ((size_t)sl * MS + (row - MP)) * DM))[lane + 64 * j]; }
            s += (fv[j][0] * fv[j][0] + fv[j][1] * fv[j][1]) + (fv[j][2] * fv[j][2] + fv[j][3] * fv[j][3]); }
        const float r1 = rsqrtf(wave_sum(s) * (1.0f / DM) + RMS_EPS);
#pragma unroll
        for (int j = 0; j < 4; ++j) { const f32x4 g = ((const f32x4*)p.g_ffn_post)[lane + 64 * j]; const f32x4 x = ((const f32x4*)(X1 + (size_t)row * DM))[lane + 64 * j];
            ((f32x4*)(p.out + O_Y + (size_t)row * DM))[lane + 64 * j] = x + fv[j] * r1 * g; }
    }
}

constexpr int N_PHASES = 11;
#ifndef NW_P1
#define NW_P1 256
#endif
#ifndef NW_P7
#define NW_P7 256
#endif
constexpr int LDS_BYTES = pg8::STAGE_BYTES + 16 + 4096;
__global__ void __launch_bounds__(512, 2) fwd_kernel(Params p) {
    extern __shared__ __attribute__((aligned(16))) unsigned char lds_raw[];
    LAS unsigned char* lds = (LAS unsigned char*)lds_raw;
    cg::grid_group grid = cg::this_grid();
    unsigned char* ws = p.ws;
    const bf16_t* QKVG = (const bf16_t*)(ws + WS_QKVG);
#ifndef PHMASK
#define PHMASK 0x7ff
#endif
#ifndef REPLAY_HI
#define REPLAY_HI 0
#endif
#define PH(k) (((PHMASK >> (k)) & 1) && p.ph_lo <= (k) && (k) < p.ph_hi)
    volatile LAS unsigned* bst = (volatile LAS unsigned*)(lds + pg8::STAGE_BYTES);
    if (threadIdx.x < 4) bst[threadIdx.x] = 0u;
    __syncthreads();
    const XcdBarrier xbar = xcd_barrier_post((unsigned*)(ws + WS_BAR + (size_t)p.bar_sel * 16384), bst);
    if (p.ph_lo < 0) grid.sync();
#define SEAM(k) do { if ((k) + 1 < p.ph_hi) xcd_barrier(xbar); } while (0)
#ifndef DBLMASK
#define DBLMASK 0
#endif
#define REP(k) for (int rep_ = 0; rep_ < 1 + ((DBLMASK >> (k)) & 1); ++rep_)
    const bool cw = (int)blockIdx.x >= NWK;
    if (PH(0)) { if (cw) copy_dedicated(p, 0, NWK); else { REP(0) phase_prologue(p, lds); signal_done(p, 0); } SEAM(0); }
    if (PH(1)) { if (cw) copy_dedicated(p, 1, NWK); else { REP(1) { EpiStoreQkvg e; e.O = (bf16_t*)(ws + WS_QKVG); run_gemm(lds, (const bf16_t*)(ws + WS_H), (const bf16_t*)(ws + WS_WIN), MT, INC, DM, e, NWK); } copy_helper(p, lds, 1, NWK, true); } SEAM(1); }
    if (PH(2)) { if (cw) copy_dedicated(p, 2, NWK); else { REP(2) phase_attention(p, lds); signal_done(p, 2); } SEAM(2); }
    if (PH(3)) { if (cw) copy_dedicated(p, 3, NWK); else { REP(3) phase_combine(p); copy_helper(p, lds, 3, 0u, true, 1); } SEAM(3); }
    if (PH(4)) { if (cw) copy_dedicated(p, 4, NWK); else { REP(4) { EpiGateAB e; e.T1 = (bf16_t*)(ws + WS_T1); e.QKVG = QKVG; e.O = (bf16_t*)(ws + WS_H);
        pg8::Gemm g; g.A = (const bf16_t*)(ws + WS_OA); g.Bt = (const bf16_t*)(ws + WS_WA); g.M = MT; g.N = DM; g.K = 768;
        PairOrder S; S.init(NWK, (int)blockIdx.x);
        pg8::gemm_phase<EpiGateAB, PairOrder, true, true>(lds, g, S, e);
        } copy_helper(p, lds, 4, NWK, true); } SEAM(4); }
    if (PH(5)) { REP(5) { EpiStoreF32Split e; e.O = (bf16_t*)(ws + WS_T1); e.PART = (float*)(ws + WS_PART); e.kslice = DM / KS5; run_gemm_split(lds, (const bf16_t*)(ws + WS_H), (const bf16_t*)(ws + WS_WOUT), DM, DM, KS5, e); } copy_helper(p, lds, 5, gridDim.x, true); SEAM(5); }
    if (PH(6)) { if (cw) copy_dedicated(p, 6, NWK); else { REP(6) phase_norm_mid(p); signal_done(p, 6); } SEAM(6); }
    if (PH(7)) { if (cw) copy_dedicated(p, 7, NWK); else { REP(7) { EpiConvGelu e; e.U = (bf16_t*)(ws + WS_U); e.AG = (bf16_t*)(ws + WS_AG); e.conv_w = p.conv_w; e.conv_b = p.conv_b; e.hal = (LAS float*)(lds + LDS_HALO_OFF); run_gemm(lds, (const bf16_t*)(ws + WS_H), (const bf16_t*)(ws + WS_WUP), MT, 2 * DFF, DM, e, NWK); } copy_helper(p, lds, 7, NWK, true); } SEAM(7); }
    if (PH(8)) { if (cw) copy_dedicated(p, 8, NWK); else { REP(8) phase_conv(p); signal_done(p, 8); } SEAM(8); }
    if (PH(9)) { REP(9) { EpiStoreF32Split e; e.O = (bf16_t*)(ws + WS_T1); e.PART = (float*)(ws + WS_PART); e.kslice = DFF / KS9; run_gemm_split(lds, (const bf16_t*)(ws + WS_U), (const bf16_t*)(ws + WS_WDN), DM, DFF, KS9, e); } copy_helper(p, lds, 9, gridDim.x, true); SEAM(9); }
    if (PH(10)) { if (!cw) { REP(10) phase_norm_out(p); } copy_helper(p, lds, 10, 0u, false, 2); }
}

#ifndef MK_SINGLE
#define MK_SINGLE 1
#endif
extern "C" void kernel_launch(void* const* d_in, const int* in_sizes, int n_in, void* d_out, int out_size, void* d_ws, size_t ws_size, hipStream_t stream) {
    static int grid = 0;
    if (grid == 0) {
        if (n_in != 20 || (size_t)out_size != O_END || ws_size < WS_END) { fprintf(stderr, "kernel_launch: unexpected shapes: n_in %d out %d ws %zu (need %zu)\n", n_in, out_size, ws_size, (size_t)WS_END); grid = -1; return; }
        int dev = 0, cus = 0, per_cu = 0;
        hipGetDevice(&dev); hipDeviceGetAttribute(&cus, hipDeviceAttributeMultiprocessorCount, dev);
        if (hipFuncSetAttribute((const void*)fwd_kernel, hipFuncAttributeMaxDynamicSharedMemorySize, LDS_BYTES) != hipSuccess) { fprintf(stderr, "kernel_launch: hipFuncSetAttribute failed\n"); grid = -1; return; }
        if (hipOccupancyMaxActiveBlocksPerMultiprocessor(&per_cu, (const void*)fwd_kernel, 512, LDS_BYTES) != hipSuccess || per_cu < 1) { fprintf(stderr, "kernel_launch: occupancy query says %d\n", per_cu); per_cu = 1; }
        (void)hipGetLastError();
        grid = cus * 1;
    }
    if (grid < 0) return;
    if (hipMemsetAsync((char*)d_ws + WS_CTL, 0, WS_END - WS_CTL, stream) != hipSuccess) { fprintf(stderr, "kernel_launch: memset of control words failed\n"); return; }
    Params p{};
    const float** pp = (const float**)&p;
    for (int i = 0; i < 20; ++i) pp[i] = (const float*)d_in[i];
    p.out = (float*)d_out; p.ws = (unsigned char*)d_ws;
#if MK_SINGLE
    p.ph_lo = 0; p.ph_hi = N_PHASES;
    void* args[] = {&p};
    hipError_t e = hipLaunchCooperativeKernel((const void*)fwd_kernel, dim3(grid), dim3(512), args, LDS_BYTES, stream);
    if (e != hipSuccess) fprintf(stderr, "cooperative launch failed: %s (grid %d)\n", hipGetErrorString(e), grid);
#if REPLAY_HI > 0
    p.ph_lo = 0; p.ph_hi = REPLAY_HI; p.bar_sel = 1;
    e = hipLaunchCooperativeKernel((const void*)fwd_kernel, dim3(grid), dim3(512), args, LDS_BYTES, stream);
#endif
#else
    for (int ph = 0; ph < N_PHASES; ++ph) {
        p.ph_lo = ph; p.ph_hi = ph + 1;
        hipLaunchKernelGGL(fwd_kernel, dim3(grid), dim3(512), LDS_BYTES, stream, p);
    }
#endif
}
```

```cpp
#include <hip/hip_runtime.h>
#include <hip/hip_cooperative_groups.h>
#include <cstdio>
#include <cstdint>
namespace cg = cooperative_groups;
namespace pg8 {
#define PG8_LAS __attribute__((address_space(3)))
typedef unsigned short bf16_t;
typedef short bf16x8 __attribute__((ext_vector_type(8)));
typedef float f32x4 __attribute__((ext_vector_type(4)));
typedef unsigned u32x4 __attribute__((ext_vector_type(4)));
constexpr int BM = 256, BK = 64, HALF = 128, HTB = HALF * BK * 2  , STAGE_BYTES = 8 * HTB, NXCD = 8, WGM = 8;

__host__ __device__ __forceinline__ int lds_byte(int r, int c) { const int st = (r >> 4) * 2 + (c >> 5), rr = r & 15, cc = c & 31, ob = rr * 64 + cc * 2; return st * 1024 + (ob ^ (((ob >> 9) & 1) << 5)); }
__host__ __device__ __forceinline__ void stage_rc(int b, int& R, int& C) { const int st = b / 1024, sb = b % 1024, swz = sb ^ (((sb >> 9) & 1) << 5); R = (st >> 1) * 16 + swz / 64; C = (st & 1) * 32 + (swz % 64) / 2; }
__host__ __device__ __forceinline__ int perm32(int rho) { const int n = rho >> 4, i = rho & 15; return 8 * (i >> 2) + 4 * n + (i & 3); }

struct Unit { int pm, pn, kofs, nt; };
struct Gemm { const bf16_t* A; const bf16_t* Bt; int M, N, K; };

struct StaticOrder {
    int nM, nN, nwg, G, c, ntf;
    __host__ __device__ void init(int M, int N, int G_, int c_) { nM = M / BM; nN = N / BM; nwg = nM * nN; G = G_; c = c_; }
    __host__ __device__ bool next(int i, Unit& u) const {
        const long L = (long)i * G + c; if (L >= nwg) return false;
        int wgid = (int)L; { const int q = nwg / NXCD, r = nwg % NXCD, xcd = wgid % NXCD, off = wgid / NXCD; wgid = (xcd < r ? xcd * (q + 1) : r * (q + 1) + (xcd - r) * q) + off; }
        const int nig = WGM * nN, gid = wgid / nig, fm = gid * WGM, gsz = (nM - fm) < WGM ? (nM - fm) : WGM;
        u.pm = fm + ((wgid % nig) % gsz); u.pn = (wgid % nig) / gsz; u.kofs = 0; u.nt = ntf; return true;
    }
    __device__ __forceinline__ void a_ready(const Unit&) const {}
    __device__ __forceinline__ void done(const Unit&) const {}
};
__device__ __forceinline__ unsigned cvt_pk_bf16(float lo, float hi) { unsigned r; asm volatile("v_cvt_pk_bf16_f32 %0, %1, %2" : "=v"(r) : "v"(lo), "v"(hi)); return r; }
template <class Epi, class Sched, bool ALIGN_EPI = false, bool SP2 = false>
__device__ __forceinline__ void gemm_phase(PG8_LAS unsigned char* lds, const Gemm g, const Sched& S, const Epi& E) {
    const int tid = threadIdx.x, wid = __builtin_amdgcn_readfirstlane(tid >> 6), lane = tid & 63, wr = wid >> 2, wc = wid & 3, fr = lane & 15, fq = lane >> 4;
    const int K = g.K;
    unsigned voffA[2], voffB[2];
#pragma unroll
    for (int i = 0; i < 2; ++i) { int R, C; stage_rc(tid * 16 + i * 8192, R, C); const int Rb = Epi::PERM ? ((R & ~31) + perm32(R & 31)) : R;
        voffA[i] = (unsigned)(R * K + C) * 2u; voffB[i] = (unsigned)(Rb * K + C) * 2u; }
    const size_t kstep = (size_t)(BK * 2);
    const size_t hstep = (size_t)HALF * K * 2;
    const size_t tstep = 2 * hstep;
    const unsigned ldsw = (unsigned)wid * 1024u;
    const int aoff = lds_byte(wr * 64 + fr, fq * 8), boff = lds_byte(wc * 32 + fr, fq * 8);
#define PG8_SA(b, h) (((b) * 2 + (h)) * HTB)
#define PG8_SB(b, h) ((4 + (b) * 2 + (h)) * HTB)
#define PG8_STAGE(bufoff, gbase, voff) do { _Pragma("unroll") for (int _i = 0; _i < 2; ++_i) \
        __builtin_amdgcn_global_load_lds((const unsigned*)((const char*)(gbase) + (voff)[_i]), (PG8_LAS unsigned*)(lds + (bufoff) + ldsw + _i * 8192), 16, 0, 0); } while (0)
#define PG8_LDA(dst, b, h) do { _Pragma("unroll") for (int m = 0; m < 4; ++m) _Pragma("unroll") for (int k = 0; k < 2; ++k) dst[m][k] = *(const PG8_LAS bf16x8*)(lds + PG8_SA(b, h) + aoff + m * 2048 + k * 1024); } while (0)
#define PG8_LDB(dst, b, h) do { _Pragma("unroll") for (int n = 0; n < 2; ++n) _Pragma("unroll") for (int k = 0; k < 2; ++k) dst[n][k] = *(const PG8_LAS bf16x8*)(lds + PG8_SB(b, h) + boff + n * 2048 + k * 1024); } while (0)
#define PG8_MMA(ai, bj, At, Bt) do { __builtin_amdgcn_s_setprio(1); _Pragma("unroll") for (int m = 0; m < 4; ++m) _Pragma("unroll") for (int n = 0; n < 2; ++n) _Pragma("unroll") for (int k = 0; k < 2; ++k) \
        acc[ai][bj][m][n] = __builtin_amdgcn_mfma_f32_16x16x32_bf16(Bt[n][k], At[m][k], acc[ai][bj][m][n], 0, 0, 0); __builtin_amdgcn_s_setprio(0); } while (0)
#define PG8_WAIT_V(n) asm volatile("s_waitcnt vmcnt(" #n ")" ::: "memory")
#define PG8_WAIT_L(n) asm volatile("s_waitcnt lgkmcnt(" #n ")" ::: "memory")
#define PG8_BAR __builtin_amdgcn_s_barrier()
#define PG8_SCHED __builtin_amdgcn_sched_barrier(0)
    Unit cur, nxt; int ui = 0;
    if (!S.next(0, cur)) return;
    f32x4 acc[2][2][4][2];
#pragma unroll
    for (int a = 0; a < 2; ++a)
#pragma unroll
        for (int b = 0; b < 2; ++b)
#pragma unroll
            for (int m = 0; m < 4; ++m)
#pragma unroll
                for (int n = 0; n < 2; ++n) acc[a][b][m][n] = (f32x4){0.f, 0.f, 0.f, 0.f};
    bf16x8 At[4][2], B0[2][2], B1[2][2];
    const char* cA = (const char*)g.A + (size_t)cur.pm * tstep + (size_t)cur.kofs * 2; const char* cB = (const char*)g.Bt + (size_t)cur.pn * tstep + (size_t)cur.kofs * 2;
    S.a_ready(cur);
    if constexpr (SP2) {
        PG8_STAGE(PG8_SB(0, 0), cB, voffB); PG8_STAGE(PG8_SB(0, 1), cB + hstep, voffB); PG8_STAGE(PG8_SA(0, 0), cA, voffA); PG8_STAGE(PG8_SA(0, 1), cA + hstep, voffA);
        if (wr == 1) PG8_BAR;
        PG8_WAIT_V(2); PG8_BAR;
        PG8_STAGE(PG8_SB(1, 0), cB + kstep, voffB); PG8_STAGE(PG8_SA(1, 0), cA + kstep, voffA); PG8_STAGE(PG8_SB(1, 1), cB + hstep + kstep, voffB);
        PG8_WAIT_V(6); PG8_BAR;
    } else {
        PG8_STAGE(PG8_SB(0, 0), cB, voffB); PG8_STAGE(PG8_SA(0, 0), cA, voffA); PG8_STAGE(PG8_SB(0, 1), cB + hstep, voffB); PG8_STAGE(PG8_SA(0, 1), cA + hstep, voffA);
        if (wr == 1) PG8_BAR;
        PG8_WAIT_V(4); PG8_BAR;
        PG8_STAGE(PG8_SB(1, 0), cB + kstep, voffB); PG8_STAGE(PG8_SA(1, 0), cA + kstep, voffA); PG8_STAGE(PG8_SB(1, 1), cB + hstep + kstep, voffB);
        PG8_WAIT_V(6); PG8_BAR;
    }
    for (;;) {
        const bool has_next = S.next(ui + 1, nxt);
        const char* nA = has_next ? (const char*)g.A + (size_t)nxt.pm * tstep + (size_t)nxt.kofs * 2 : cA; const char* nB = has_next ? (const char*)g.Bt + (size_t)nxt.pn * tstep + (size_t)nxt.kofs * 2 : cB;
        const int nt = cur.nt;
        for (int t = 0; t < nt; t += 2) {
            const bool last = (t == nt - 2);
            const char* a1 = cA + (size_t)(t + 1) * kstep;
            const char* a2 = last ? nA : cA + (size_t)(t + 2) * kstep; const char* b2 = last ? nB : cB + (size_t)(t + 2) * kstep;
            const char* a3 = a2 + kstep; const char* b3 = b2 + kstep;
            if (last && has_next) S.a_ready(nxt);
            if constexpr (SP2) {
            PG8_LDB(B0, 0, 0); PG8_LDB(B1, 0, 1); PG8_SCHED; PG8_LDA(At, 0, 0); PG8_STAGE(PG8_SA(1, 1), a1 + hstep, voffA);
            PG8_WAIT_V(8); PG8_WAIT_L(0); PG8_BAR; PG8_MMA(0, 0, At, B0); PG8_MMA(0, 1, At, B1); PG8_BAR; PG8_SCHED;
            PG8_LDA(At, 0, 1); PG8_STAGE(PG8_SB(0, 0), b2, voffB); PG8_STAGE(PG8_SB(0, 1), b2 + hstep, voffB); PG8_STAGE(PG8_SA(0, 0), a2, voffA);
            PG8_WAIT_V(8); PG8_WAIT_L(0); PG8_BAR; PG8_MMA(1, 0, At, B0); PG8_MMA(1, 1, At, B1); PG8_BAR; PG8_SCHED;
            PG8_LDB(B0, 1, 0); PG8_LDB(B1, 1, 1); PG8_SCHED; PG8_LDA(At, 1, 0); PG8_STAGE(PG8_SA(0, 1), a2 + hstep, voffA);
            PG8_WAIT_V(8); PG8_WAIT_L(0); PG8_BAR; PG8_MMA(0, 0, At, B0); PG8_MMA(0, 1, At, B1); PG8_BAR; PG8_SCHED;
            PG8_LDA(At, 1, 1); PG8_STAGE(PG8_SB(1, 0), b3, voffB); PG8_STAGE(PG8_SB(1, 1), b3 + hstep, voffB); PG8_STAGE(PG8_SA(1, 0), a3, voffA);
            PG8_WAIT_V(8); PG8_WAIT_L(0); PG8_BAR; PG8_MMA(1, 0, At, B0); PG8_MMA(1, 1, At, B1); PG8_BAR; PG8_SCHED;
            } else {
            PG8_LDB(B0, 0, 0); PG8_SCHED; PG8_LDA(At, 0, 0); PG8_STAGE(PG8_SA(1, 1), a1 + hstep, voffA);
            PG8_WAIT_L(8); PG8_BAR; PG8_WAIT_L(0); PG8_MMA(0, 0, At, B0); PG8_BAR; PG8_SCHED;
            PG8_LDB(B1, 0, 1); PG8_STAGE(PG8_SB(0, 0), b2, voffB);
            PG8_BAR; PG8_WAIT_L(0); PG8_MMA(0, 1, At, B1); PG8_BAR;
            PG8_LDA(At, 0, 1); PG8_STAGE(PG8_SA(0, 0), a2, voffA);
            PG8_BAR; PG8_WAIT_L(0); PG8_MMA(1, 0, At, B0); PG8_BAR; PG8_SCHED;
            PG8_STAGE(PG8_SB(0, 1), b2 + hstep, voffB);
            PG8_WAIT_V(6); PG8_BAR; PG8_MMA(1, 1, At, B1); PG8_BAR;
            PG8_LDB(B0, 1, 0); PG8_SCHED; PG8_LDA(At, 1, 0); PG8_STAGE(PG8_SA(0, 1), a2 + hstep, voffA);
            PG8_WAIT_L(8); PG8_BAR; PG8_WAIT_L(0); PG8_MMA(0, 0, At, B0); PG8_BAR; PG8_SCHED;
            PG8_LDB(B1, 1, 1); PG8_STAGE(PG8_SB(1, 0), b3, voffB);
            PG8_BAR; PG8_WAIT_L(0); PG8_MMA(0, 1, At, B1); PG8_BAR;
            PG8_LDA(At, 1, 1); PG8_STAGE(PG8_SA(1, 0), a3, voffA);
            PG8_BAR; PG8_WAIT_L(0); PG8_MMA(1, 0, At, B0); PG8_BAR; PG8_SCHED;
            PG8_STAGE(PG8_SB(1, 1), b3 + hstep, voffB);
            PG8_WAIT_V(6); PG8_BAR; PG8_MMA(1, 1, At, B1); PG8_BAR;
            }
        }
        if constexpr (ALIGN_EPI) { if (wr == 0) PG8_BAR; }
        if constexpr (!Epi::AFTER_DRAIN) { E(acc, cur, wr, wc, fr, fq); S.done(cur); }
        if (!has_next) break;
#pragma unroll
        for (int a = 0; a < 2; ++a)
#pragma unroll
            for (int b = 0; b < 2; ++b)
#pragma unroll
                for (int m = 0; m < 4; ++m)
#pragma unroll
                    for (int n = 0; n < 2; ++n) acc[a][b][m][n] = (f32x4){0.f, 0.f, 0.f, 0.f};
        cur = nxt; cA = nA; cB = nB; ++ui;
        if constexpr (ALIGN_EPI) { if (wr == 1) PG8_BAR; }
    }
    PG8_WAIT_V(0);
    if constexpr (!ALIGN_EPI) { if (wr == 0) PG8_BAR; }
    PG8_BAR;
    if constexpr (Epi::AFTER_DRAIN) { E.fused(acc, cur, wr, wc, fr, fq, lds, wid, lane); S.done(cur); }
#undef PG8_SA
#undef PG8_SB
#undef PG8_STAGE
#undef PG8_LDA
#undef PG8_LDB
#undef PG8_MMA
#undef PG8_WAIT_V
#undef PG8_WAIT_L
#undef PG8_BAR
#undef PG8_SCHED
}
}
#define LAS __attribute__((address_space(3)))
typedef unsigned short bf16_t;
using pg8::f32x4; using pg8::u32x4; using pg8::bf16x8;
typedef short s16x4 __attribute__((ext_vector_type(4)));
typedef unsigned u32x2 __attribute__((ext_vector_type(2)));

constexpr int DM = 1024, NBATCH = 8, SEQ = 2048, DBATCH = 128, DSEQ = 4;
constexpr int MP = NBATCH * SEQ, MS = DBATCH * DSEQ, MT = MP + MS;
constexpr int INC = 5120, DFF = 4096;
constexpr int C_QA = 0, C_KA = 512, C_VA = 640, C_QB = 768, C_KB = 1536, C_VB = 2304, C_GA = 3072, C_GB = 4096;
constexpr float RMS_EPS = 1e-6f, LOG2E = 1.4426950408889634f, LN2 = 0.6931471805599453f;
constexpr float SC2 = 0.125f * LOG2E;

constexpr size_t O_Y = 0;
constexpr size_t O_NAP = (size_t)MT * DM;
constexpr size_t O_NAS = O_NAP + (size_t)NBATCH * 128 * 256;
constexpr size_t O_NB1P = O_NAS + (size_t)DBATCH * 128 * 256;
constexpr size_t O_NB1S = O_NB1P + (size_t)NBATCH * 128 * 512;
constexpr size_t O_NB2P = O_NB1S + (size_t)DBATCH * 128 * 512;
constexpr size_t O_NB2S = O_NB2P + (size_t)NBATCH * 512 * 512;
constexpr size_t O_NB3P = O_NB2S + (size_t)DBATCH * 512 * 512;
constexpr size_t O_NB3S = O_NB3P + (size_t)NBATCH * 2048 * 512;
constexpr size_t O_NCP = O_NB3S + (size_t)DBATCH * 2048 * 512;
constexpr size_t O_NCS = O_NCP + (size_t)NBATCH * 2 * DFF;
constexpr size_t O_END = O_NCS + (size_t)DBATCH * 2 * DFF;

constexpr size_t WS_WIN = 0;
constexpr size_t WS_WA = WS_WIN + (size_t)INC * DM * 2;
constexpr size_t WS_WB = WS_WA + (size_t)DM * 512 * 2;
constexpr size_t WS_WOUT = WS_WB + (size_t)DM * 256 * 2;
constexpr size_t WS_WUP = WS_WOUT + (size_t)DM * DM * 2;
constexpr size_t WS_WDN = WS_WUP + (size_t)2 * DFF * DM * 2;
constexpr size_t WS_H = WS_WDN + (size_t)DM * DFF * 2;
constexpr size_t WS_QKVG = WS_H + (size_t)MT * DM * 2;
constexpr size_t WS_OA = WS_QKVG + (size_t)MT * INC * 2;
constexpr size_t WS_OB = WS_OA + (size_t)MT * 512 * 2;
constexpr size_t WS_OG = WS_OB + (size_t)MT * 256 * 2;
constexpr size_t WS_LSE = WS_OG + (size_t)3 * MP * 256 * 4;
constexpr size_t WS_T1 = WS_LSE + (size_t)3 * MP * 4 * 4;
constexpr size_t WS_X1 = WS_T1 + (size_t)MT * DM * 4;
constexpr size_t WS_AG = WS_X1 + (size_t)MT * DM * 4;
constexpr size_t WS_U = WS_AG + (size_t)MT * 2 * DFF * 2;
constexpr size_t WS_PART = WS_U + (size_t)MT * DFF * 2;
constexpr size_t WS_CTL = WS_PART + (size_t)16 * MS * DM * 4;
constexpr size_t WS_BAR = WS_CTL + 4096;
constexpr size_t WS_END = WS_BAR + 2 * 16384;

#ifndef NCW
#define NCW 0
#endif
#define NWK ((int)gridDim.x - NCW)
struct Params {
    const float *x_prompt, *x_sample, *cache_a, *cache_b1, *cache_b2, *cache_b3, *state_conv, *w_in, *sinks_a, *w_a, *w_b, *w_out,
        *g_mix_pre, *g_mix_post, *g_ffn_pre, *g_ffn_post, *w_up, *conv_w, *conv_b, *w_down;
    float* out; unsigned char* ws; int ph_lo, ph_hi, bar_sel, pad_;
};

__device__ __forceinline__ float bf2f(unsigned short h) { return __uint_as_float((unsigned)h << 16); }
__device__ __forceinline__ unsigned pk2(float lo, float hi) { return pg8::cvt_pk_bf16(lo, hi); }
__device__ __forceinline__ float bflo(unsigned w) { return __uint_as_float(w << 16); }
__device__ __forceinline__ float bfhi(unsigned w) { return __uint_as_float(w & 0xffff0000u); }
__device__ __forceinline__ float wave_sum(float v) {
#pragma unroll
    for (int o = 1; o < 64; o <<= 1) v += __shfl_xor(v, o);
    return v;
}
__device__ __forceinline__ float sigmoidf_(float x) { return 1.0f / (1.0f + __builtin_amdgcn_exp2f(-x * LOG2E)); }
__device__ __forceinline__ float ex2(float x) { return __builtin_amdgcn_exp2f(x); }

#define EPI_LOOP_BEGIN \
    const int row0 = u.pm * 256 + wr * 64 + fr, col0 = u.pn * 256 + wc * 32 + 8 * fq; \
    _Pragma("unroll") for (int ai = 0; ai < 2; ++ai) _Pragma("unroll") for (int m = 0; m < 4; ++m) { const size_t row = (size_t)(row0 + ai * 128 + m * 16); \
    _Pragma("unroll") for (int bj = 0; bj < 2; ++bj) { const int col = col0 + bj * 128; f32x4 v0 = acc[ai][bj][m][0], v1 = acc[ai][bj][m][1];
#define EPI_LOOP_END asm volatile("" ::: "memory"); } }

struct EpiStoreBf16 {
    static constexpr bool PERM = true, AFTER_DRAIN = false; bf16_t* O; int ldc;
    __device__ __forceinline__ void operator()(const f32x4 (&acc)[2][2][4][2], const pg8::Unit& u, int wr, int wc, int fr, int fq) const {
        EPI_LOOP_BEGIN
            u32x4 w; w.x = pk2(v0[0], v0[1]); w.y = pk2(v0[2], v0[3]); w.z = pk2(v1[0], v1[1]); w.w = pk2(v1[2], v1[3]);
            *(u32x4*)(O + row * ldc + col) = w;
        EPI_LOOP_END
    }
};
struct EpiStoreQkvg {
    static constexpr bool PERM = true, AFTER_DRAIN = false; bf16_t* O;
    __device__ __forceinline__ void operator()(const f32x4 (&acc)[2][2][4][2], const pg8::Unit& u, int wr, int wc, int fr, int fq) const {
        const bool gate = u.pn * 256 >= C_GA;
        EPI_LOOP_BEGIN
            if (gate) { v0[0] = sigmoidf_(v0[0]); v0[1] = sigmoidf_(v0[1]); v0[2] = sigmoidf_(v0[2]); v0[3] = sigmoidf_(v0[3]); v1[0] = sigmoidf_(v1[0]); v1[1] = sigmoidf_(v1[1]); v1[2] = sigmoidf_(v1[2]); v1[3] = sigmoidf_(v1[3]); }
            u32x4 w; w.x = pk2(v0[0], v0[1]); w.y = pk2(v0[2], v0[3]); w.z = pk2(v1[0], v1[1]); w.w = pk2(v1[2], v1[3]);
            *(u32x4*)(O + row * INC + col) = w;
        EPI_LOOP_END
    }
};
struct EpiStoreF32 {
    static constexpr bool PERM = true, AFTER_DRAIN = false; float* O; int ldc;
    __device__ __forceinline__ void operator()(const f32x4 (&acc)[2][2][4][2], const pg8::Unit& u, int wr, int wc, int fr, int fq) const {
        EPI_LOOP_BEGIN
            *(f32x4*)(O + row * ldc + col) = v0; *(f32x4*)(O + row * ldc + col + 4) = v1;
        EPI_LOOP_END
    }
};
struct EpiGateAB {
    static constexpr bool PERM = true, AFTER_DRAIN = false; bf16_t* T1; const bf16_t* QKVG; bf16_t* O;
    __device__ __forceinline__ void operator()(const f32x4 (&acc)[2][2][4][2], const pg8::Unit& u, int wr, int wc, int fr, int fq) const {
        if (u.kofs == 0) {
            EPI_LOOP_BEGIN
                const u32x4 g = *(const u32x4*)(QKVG + row * INC + C_GA + col);
                u32x4 w; w.x = pk2(v0[0] * bflo(g.x), v0[1] * bfhi(g.x)); w.y = pk2(v0[2] * bflo(g.y), v0[3] * bfhi(g.y)); w.z = pk2(v1[0] * bflo(g.z), v1[1] * bfhi(g.z)); w.w = pk2(v1[2] * bflo(g.w), v1[3] * bfhi(g.w));
                *(u32x4*)(T1 + row * DM + col) = w;
            EPI_LOOP_END
        } else {
            EPI_LOOP_BEGIN
                const u32x4 g = *(const u32x4*)(QKVG + row * INC + C_GB + col);
                const u32x4 t = *(const u32x4*)(T1 + row * DM + col);
                u32x4 w; w.x = pk2(bflo(t.x) + v0[0] * bflo(g.x), bfhi(t.x) + v0[1] * bfhi(g.x)); w.y = pk2(bflo(t.y) + v0[2] * bflo(g.y), bfhi(t.y) + v0[3] * bfhi(g.y));
                w.z = pk2(bflo(t.z) + v1[0] * bflo(g.z), bfhi(t.z) + v1[1] * bfhi(g.z)); w.w = pk2(bflo(t.w) + v1[2] * bflo(g.w), bfhi(t.w) + v1[3] * bfhi(g.w));
                *(u32x4*)(O + row * DM + col) = w;
            EPI_LOOP_END
        }
    }
};
struct PairOrder {
    pg8::StaticOrder so;
    __device__ void init(int G_, int c_) { so.init(MT, DM, G_, c_); so.ntf = 0; }
    __device__ bool next(int i, pg8::Unit& u) const { if (!so.next(i >> 1, u)) return false; if (i & 1) { u.kofs = 512; u.nt = 4; } else { u.kofs = 0; u.nt = 8; } return true; }
    __device__ __forceinline__ void a_ready(const pg8::Unit&) const {}
    __device__ __forceinline__ void done(const pg8::Unit&) const {}
};

__device__ __forceinline__ float dpp_ror1(float x) { return __builtin_bit_cast(float, __builtin_amdgcn_update_dpp(0, __builtin_bit_cast(int, x), 0x121, 0xf, 0xf, false)); }
__device__ __forceinline__ float dpp_ror2(float x) { return __builtin_bit_cast(float, __builtin_amdgcn_update_dpp(0, __builtin_bit_cast(int, x), 0x122, 0xf, 0xf, false)); }
__device__ __forceinline__ float gelu_tanh_f(float x) {
    const float t = 0.7978845608028654f * (x + 0.044715f * x * x * x);
    const float e = ex2(2.0f * LOG2E * t);
    return 0.5f * x * (2.0f - 2.0f / (1.0f + e));
}
constexpr int LDS_HALO_OFF = pg8::STAGE_BYTES + 16;
struct EpiConvGelu {
    static constexpr bool PERM = true, AFTER_DRAIN = false;
    bf16_t* U; bf16_t* AG; const float* conv_w; const float* conv_b; LAS float* hal;
    __device__ __forceinline__ void store_raw(const f32x4 (&acc)[2][2][4][2], int ai, int m, size_t row, int f0) const {
#pragma unroll
        for (int bj = 0; bj < 2; ++bj) { const f32x4 v0 = acc[ai][bj][m][0], v1 = acc[ai][bj][m][1];
            u32x4 w; w.x = pk2(v0[0], v0[1]); w.y = pk2(v0[2], v0[3]); w.z = pk2(v1[0], v1[1]); w.w = pk2(v1[2], v1[3]);
            *(u32x4*)(AG + row * (2 * DFF) + bj * DFF + f0) = w; }
    }
    __device__ __forceinline__ void operator()(const f32x4 (&acc)[2][2][4][2], const pg8::Unit& u, int wr, int wc, int fr, int fq) const {
        const int f0 = u.pn * 128 + wc * 32 + 8 * fq, cl = wc * 32 + 8 * fq;
        const size_t rowt = (size_t)u.pm * 256 + wr * 64 + fr;
        if (u.pm >= MP / 256) {
#pragma unroll
            for (int ai = 0; ai < 2; ++ai)
#pragma unroll
                for (int m = 0; m < 4; ++m) store_raw(acc, ai, m, rowt + ai * 128 + m * 16, f0);
            return;
        }
        if (wr == 0 && fr < 2) store_raw(acc, 0, 0, rowt, f0);
        if (wr == 1 && fr >= 14) store_raw(acc, 1, 3, rowt + 128 + 48, f0);
        if (fr >= 14) {
#pragma unroll
            for (int ai = 0; ai < 2; ++ai)
#pragma unroll
                for (int n = 0; n < 2; ++n) *(LAS f32x4*)(hal + (((2 * ai + wr) * 2 + (fr - 14)) * 128 + cl + 4 * n)) = acc[ai][0][3][n];
        }
        asm volatile("s_waitcnt lgkmcnt(0)" ::: "memory"); __builtin_amdgcn_s_barrier(); asm volatile("" ::: "memory");
        f32x4 w0[2], w1[2], w2[2], cb[2];
#pragma unroll
        for (int n = 0; n < 2; ++n) { w0[n] = *(const f32x4*)(conv_w + f0 + 4 * n); w1[n] = *(const f32x4*)(conv_w + DFF + f0 + 4 * n); w2[n] = *(const f32x4*)(conv_w + 2 * DFF + f0 + 4 * n); cb[n] = *(const f32x4*)(conv_b + f0 + 4 * n); }
#pragma unroll
        for (int ai = 0; ai < 2; ++ai) {
            const int blk = 2 * ai + wr;
            f32x4 h1[2], h2[2];
#pragma unroll
            for (int n = 0; n < 2; ++n) { h1[n] = (f32x4){0.f, 0.f, 0.f, 0.f}; h2[n] = h1[n];
                if (blk >= 1 && fr < 2) { h1[n] = *(const LAS f32x4*)(hal + (((blk - 1) * 2 + 1) * 128 + cl + 4 * n)); h2[n] = *(const LAS f32x4*)(hal + (((blk - 1) * 2 + 0) * 128 + cl + 4 * n)); } }
            f32x4 uo[4][2];
#pragma unroll
            for (int n = 0; n < 2; ++n)
#pragma unroll
                for (int j = 0; j < 4; ++j) {
                    float r1p = h1[n][j], r2p = (fr == 1) ? h1[n][j] : h2[n][j];
#pragma unroll
                    for (int m = 0; m < 4; ++m) {
                        const float x = acc[ai][0][m][n][j];
                        const float r1 = dpp_ror1(x), r2 = dpp_ror2(x);
                        const float p1 = fr >= 1 ? r1 : r1p, p2 = fr >= 2 ? r2 : r2p;
                        const float cv = cb[n][j] + w0[n][j] * p2 + w1[n][j] * p1 + w2[n][j] * x;
                        uo[m][n][j] = gelu_tanh_f(cv) * acc[ai][1][m][n][j];
                        r1p = r1; r2p = r2;
                    }
                }
#pragma unroll
            for (int m = 0; m < 4; ++m) { u32x4 w; w.x = pk2(uo[m][0][0], uo[m][0][1]); w.y = pk2(uo[m][0][2], uo[m][0][3]); w.z = pk2(uo[m][1][0], uo[m][1][1]); w.w = pk2(uo[m][1][2], uo[m][1][3]);
                *(u32x4*)(U + (rowt + ai * 128 + m * 16) * DFF + f0) = w; }
        }
    }
};

template <class Epi>
__device__ __forceinline__ void run_gemm(LAS unsigned char* lds, const bf16_t* A, const bf16_t* Bt, int M, int N, int K, const Epi& E, int nwork = 0) {
    asm volatile("" : "+s"(K));
    if (nwork <= 0) nwork = (int)gridDim.x;
    if ((int)blockIdx.x >= nwork) return;
    pg8::Gemm g; g.A = A; g.Bt = Bt; g.M = M; g.N = N; g.K = K;
    pg8::StaticOrder S; S.init(M, N, nwork, (int)blockIdx.x); S.ntf = K / pg8::BK;
    pg8::gemm_phase<Epi, pg8::StaticOrder, true, true>(lds, g, S, E);
}

struct SplitOrder {
    pg8::StaticOrder so; int nfull, nsub, ksplit, nts, G, c;
    __device__ void init(int N, int K, int ksplit_, int G_, int c_) { so.init(MP, N, G_, c_); so.ntf = K / pg8::BK; nfull = so.nwg; ksplit = ksplit_; nts = (K / ksplit_) / pg8::BK; nsub = (MS / 256) * (N / 256) * ksplit_; G = G_; c = c_; }
    __device__ bool next(int i, pg8::Unit& u) const {
        const long L = (long)i * G + c;
        if (L < nfull) return so.next(i, u);
        const int sidx = (int)(L - nfull); if (sidx >= nsub) return false;
        const int sl = sidx % ksplit, t = sidx / ksplit, nN = so.nN;
        u.pn = t % nN; u.pm = MP / 256 + t / nN; u.kofs = sl * nts * pg8::BK; u.nt = nts; return true;
    }
    __device__ __forceinline__ void a_ready(const pg8::Unit&) const {}
    __device__ __forceinline__ void done(const pg8::Unit&) const {}
};
struct EpiStoreF32Split {
    static constexpr bool PERM = true, AFTER_DRAIN = false; bf16_t* O; float* PART; int kslice;
    __device__ __forceinline__ void operator()(const f32x4 (&acc)[2][2][4][2], const pg8::Unit& u, int wr, int wc, int fr, int fq) const {
        if (u.pm >= MP / 256) {
            float* base = PART + ((ptrdiff_t)(u.kofs / kslice) * MS - (ptrdiff_t)MP) * DM;
            EPI_LOOP_BEGIN
                *(f32x4*)(base + row * DM + col) = v0; *(f32x4*)(base + row * DM + col + 4) = v1;
            EPI_LOOP_END
        } else {
            EPI_LOOP_BEGIN
                u32x4 w; w.x = pk2(v0[0], v0[1]); w.y = pk2(v0[2], v0[3]); w.z = pk2(v1[0], v1[1]); w.w = pk2(v1[2], v1[3]);
                *(u32x4*)(O + row * DM + col) = w;
            EPI_LOOP_END
        }
    }
};
template <class Epi>
__device__ __forceinline__ void run_gemm_split(LAS unsigned char* lds, const bf16_t* A, const bf16_t* Bt, int N, int K, int ksplit, const Epi& E) {
    asm volatile("" : "+s"(K));
    pg8::Gemm g; g.A = A; g.Bt = Bt; g.M = MT; g.N = N; g.K = K;
    SplitOrder S; S.init(N, K, ksplit, (int)gridDim.x, (int)blockIdx.x);
    pg8::gemm_phase<Epi, SplitOrder, true, true>(lds, g, S, E);
}

template <bool UPMAP = false>
__device__ __forceinline__ void transpose_item(const float* W, int K, int N, bf16_t* WT, LAS float* scr, int item, int lane, int ldw = 0, int koff = 0) {
    if (ldw == 0) ldw = K;
    const int nblk = N / 32, kb = item / nblk, nb = item % nblk, k0 = 64 * kb, n0 = 32 * nb;
#pragma unroll 8
    for (int i = 0; i < 32; ++i) { const int kk = 2 * i + (lane >> 5); scr[kk * 33 + (lane & 31)] = W[(size_t)(k0 + kk) * N + n0 + (lane & 31)]; }
    asm volatile("s_waitcnt lgkmcnt(0)" ::: "memory");
    const int c = lane & 7;
#pragma unroll
    for (int j = 0; j < 4; ++j) { const int n = (lane >> 3) + 8 * j; const LAS float* s = scr + (8 * c) * 33 + n;
        u32x4 o; o.x = pk2(s[0 * 33], s[1 * 33]); o.y = pk2(s[2 * 33], s[3 * 33]); o.z = pk2(s[4 * 33], s[5 * 33]); o.w = pk2(s[6 * 33], s[7 * 33]);
        int drow = n0 + n;
        if (UPMAP) { const int f = drow & (DFF - 1), isg = drow >> 12; drow = 256 * (f >> 7) + 128 * isg + (f & 127); }
        *(u32x4*)(WT + (size_t)drow * ldw + koff + k0 + 8 * c) = o; }
    asm volatile("s_waitcnt lgkmcnt(0)" ::: "memory");
}

constexpr unsigned CH_ALL = 128u * 128u * 1536u / 1024u;
__device__ __forceinline__ void copy_any_unit(const Params& p, unsigned unit, int lane) {
    if (unit >= CH_ALL) return;
    const f32x4* s = (const f32x4*)p.cache_b3; f32x4* d = (f32x4*)(p.out + O_NB3S);
    f32x4 v[16];
#pragma unroll
    for (int k = 0; k < 16; ++k) { const unsigned idx = unit * 1024u + (unsigned)lane + 64u * k; const unsigned b = idx / 196608u, r = idx - b * 196608u, blk = r / 1536u, o = r - blk * 1536u;
        v[k] = __builtin_nontemporal_load(s + (size_t)b * 262144u + (blk * 16u + 4u) * 128u + o); }
#pragma unroll
    for (int k = 0; k < 16; ++k) { const unsigned idx = unit * 1024u + (unsigned)lane + 64u * k; const unsigned b = idx / 196608u, r = idx - b * 196608u, blk = r / 1536u, o = r - blk * 1536u;
        __builtin_nontemporal_store(v[k], d + (size_t)b * 262144u + blk * 16u * 128u + o); }
}
__device__ __forceinline__ void copy_dedicated(const Params& p, int ph, unsigned target) {
    unsigned* ctl = (unsigned*)(p.ws + WS_CTL);
    const int lane = threadIdx.x & 63;
    for (;;) {
        unsigned u = 0xffffffffu;
        if (lane == 0) { if (__hip_atomic_load(ctl + 16 + 16 * ph, __ATOMIC_RELAXED, __HIP_MEMORY_SCOPE_AGENT) < target) u = __hip_atomic_fetch_add(ctl, 1u, __ATOMIC_RELAXED, __HIP_MEMORY_SCOPE_AGENT); }
        u = (unsigned)__builtin_amdgcn_readfirstlane((int)u);
        if (u >= CH_ALL) break;
        copy_any_unit(p, u, lane);
    }
}
__device__ __forceinline__ void signal_done(const Params& p, int ph) {
    __syncthreads();
    if (threadIdx.x == 0) __hip_atomic_fetch_add((unsigned*)(p.ws + WS_CTL) + 16 + 16 * ph, 1u, __ATOMIC_RELAXED, __HIP_MEMORY_SCOPE_AGENT);
}

constexpr int I_IN = 16 * 160, I_A = 8 * 32, I_B = 4 * 32, I_OUT = 16 * 32, I_UP = 16 * 256, I_DN = 64 * 32;
constexpr unsigned T_ITEMS = I_A + I_B + I_OUT + I_UP + I_DN, T_TAKES = T_ITEMS / 8;
__device__ __forceinline__ void deferred_transpose_item(const Params& p, LAS float* scr, int r, int lane) {
    bf16_t* WT_A = (bf16_t*)(p.ws + WS_WA);
    bf16_t* WT_OUT = (bf16_t*)(p.ws + WS_WOUT); bf16_t* WT_UP = (bf16_t*)(p.ws + WS_WUP); bf16_t* WT_DN = (bf16_t*)(p.ws + WS_WDN);
    if (r < I_A) { transpose_item(p.w_a, 512, DM, WT_A, scr, r, lane, 768, 0); return; } r -= I_A;
    if (r < I_B) { transpose_item(p.w_b, 256, DM, WT_A, scr, r, lane, 768, 512); return; } r -= I_B;
    if (r < I_OUT) { transpose_item(p.w_out, DM, DM, WT_OUT, scr, r, lane); return; } r -= I_OUT;
    if (r < I_UP) { transpose_item<true>(p.w_up, DM, 2 * DFF, WT_UP, scr, r, lane); return; } r -= I_UP;
    transpose_item(p.w_down, DFF, DM, WT_DN, scr, r, lane);
}
__device__ __forceinline__ void copy_helper(const Params& p, LAS unsigned char* lds, int ph, unsigned target, bool count_me, int mode = 3) {
    unsigned* ctl = (unsigned*)(p.ws + WS_CTL);
    const int tid = threadIdx.x;
    LAS volatile unsigned* sh = (LAS volatile unsigned*)lds;
    LAS float* scr = (LAS float*)(lds + 1024) + (tid >> 6) * (64 * 33);
    __syncthreads();
    if (tid == 0 && count_me) __hip_atomic_fetch_add(ctl + 16 + 16 * ph, 1u, __ATOMIC_RELAXED, __HIP_MEMORY_SCOPE_AGENT);
    bool t_open = (mode & 1) != 0;
    for (;;) {
        if (tid == 0) {
            unsigned w = 0xffffffffu;
            if (target == 0u || __hip_atomic_load(ctl + 16 + 16 * ph, __ATOMIC_RELAXED, __HIP_MEMORY_SCOPE_AGENT) < target) {
                if (t_open) { const unsigned t = __hip_atomic_fetch_add(ctl + 1, 1u, __ATOMIC_RELAXED, __HIP_MEMORY_SCOPE_AGENT); if (t < T_TAKES) w = 0x80000000u | t; }
                if (w == 0xffffffffu && (mode & 2)) { const unsigned ch = __hip_atomic_fetch_add(ctl, 8u, __ATOMIC_RELAXED, __HIP_MEMORY_SCOPE_AGENT); if (ch < CH_ALL) w = ch; }
            }
            sh[0] = w;
        }
        __syncthreads();
        const unsigned w = sh[0];
        __syncthreads();
        if (w == 0xffffffffu) break;
        if (w & 0x80000000u) deferred_transpose_item(p, scr, (int)((w & 0x7fffffffu) * 8u) + (tid >> 6), tid & 63);
        else { t_open = false; copy_any_unit(p, w + (unsigned)(tid >> 6), tid & 63); }
    }
}

__device__ __forceinline__ void phase_prologue(const Params& p, LAS unsigned char* lds) {
    const int tid = threadIdx.x, lane = tid & 63, wid = tid >> 6;
    const int gw = blockIdx.x * 8 + wid, nw = NWK * 8;
    LAS float* scr = (LAS float*)lds + wid * (64 * 33);
    bf16_t* WT_IN = (bf16_t*)(p.ws + WS_WIN);
    for (int it = gw; it < I_IN; it += nw) transpose_item(p.w_in, DM, INC, WT_IN, scr, it, lane);
    bf16_t* H = (bf16_t*)(p.ws + WS_H);
    for (int row2 = gw * 2; row2 < MT; row2 += nw * 2) {
        f32x4 v[2][4]; float s[2] = {0.f, 0.f};
#pragma unroll
        for (int q = 0; q < 2; ++q) { const int row = row2 + q;
            const float* xr = row < MP ? p.x_prompt + (size_t)row * DM : p.x_sample + (size_t)(row - MP) * DM;
#pragma unroll
            for (int j = 0; j < 4; ++j) v[q][j] = ((const f32x4*)xr)[lane + 64 * j]; }
#pragma unroll
        for (int q = 0; q < 2; ++q)
#pragma unroll
            for (int j = 0; j < 4; ++j) s[q] += (v[q][j][0] * v[q][j][0] + v[q][j][1] * v[q][j][1]) + (v[q][j][2] * v[q][j][2] + v[q][j][3] * v[q][j][3]);
#pragma unroll
        for (int q = 0; q < 2; ++q) { const int row = row2 + q;
            const float r = rsqrtf(wave_sum(s[q]) * (1.0f / DM) + RMS_EPS);
#pragma unroll
            for (int j = 0; j < 4; ++j) { const f32x4 g = ((const f32x4*)p.g_mix_pre)[lane + 64 * j];
                u32x2 o; o.x = pk2(v[q][j][0] * r * g[0], v[q][j][1] * r * g[1]); o.y = pk2(v[q][j][2] * r * g[2], v[q][j][3] * r * g[3]);
                *(u32x2*)(H + (size_t)row * DM + (lane + 64 * j) * 4) = o; } }
    }
}
#define XB_TMO      128
#define XB_XCNT(j)  (256  + 64 * (j))
#define XB_XSUB(j)  (1280 + 64 * (j))
#define XB_XGEN(j)  (2304 + 64 * (j))
#define XB_TOP      3328
#define XB_TOPGEN   3392
#define XCD_BAR_WORDS 3456
#define XB_SPIN_CAP (1u << 18)

__device__ __forceinline__ unsigned xb_ld(unsigned* p)              { return __hip_atomic_load(p, __ATOMIC_RELAXED, __HIP_MEMORY_SCOPE_AGENT); }
__device__ __forceinline__ unsigned xb_add(unsigned* p, unsigned v) { return __hip_atomic_fetch_add(p, v, __ATOMIC_RELAXED, __HIP_MEMORY_SCOPE_AGENT); }
__device__ __forceinline__ unsigned xb_xcc_id() { return (unsigned)__builtin_amdgcn_s_getreg((3 << 11) | 20) & 0xFu; }
#define XB_SPIN(cond, bar) do { unsigned _sp = 0; while (cond) { __builtin_amdgcn_s_sleep(1); \
    if ((++_sp & 255u) == 0u) { if (xb_ld(&(bar)[XB_TMO])) break; if (_sp > XB_SPIN_CAP) { atomicAdd(&(bar)[XB_TMO], 1u); break; } } } } while (0)

struct XcdBarrier {
    unsigned* bar; unsigned x;
    volatile LAS unsigned* st;
};

__device__ __forceinline__ XcdBarrier xcd_barrier_post(unsigned* bar, volatile LAS unsigned* st) {
    XcdBarrier b; b.bar = bar; b.x = xb_xcc_id(); b.st = st;
    if (threadIdx.x == 0) (void)xb_add(&bar[XB_XCNT(b.x)], 1u);
    return b;
}
__device__ __forceinline__ void xcd_barrier_complete(unsigned* bar, unsigned x, unsigned& nloc, unsigned& nx) {
    const unsigned G = gridDim.x * gridDim.y * gridDim.z;
    unsigned sum, cnt, mine, sp = 0u;
    for (;;) {
        sum = 0u; cnt = 0u; mine = 0u;
#pragma unroll
        for (unsigned j = 0; j < 16; ++j) { const unsigned c = xb_ld(&bar[XB_XCNT(j)]); sum += c; cnt += (c > 0u) ? 1u : 0u; mine = (j == x) ? c : mine; }
        if (sum == G) break;
        __builtin_amdgcn_s_sleep(1);
        if ((++sp & 255u) == 0u) { if (xb_ld(&bar[XB_TMO])) break; if (sp > XB_SPIN_CAP) { atomicAdd(&bar[XB_TMO], 1u); break; } }
    }
    nloc = mine > 0u ? mine : 1u; nx = cnt > 0u ? cnt : 1u;
}

__device__ __forceinline__ void xcd_barrier(const XcdBarrier& b) {
    asm volatile("s_waitcnt vmcnt(0)" ::: "memory");
    __syncthreads();
    if (threadIdx.x == 0) {
        unsigned* bar = b.bar;
        __builtin_amdgcn_s_waitcnt(0);
        unsigned nloc = b.st[0], nx = b.st[1];
        if (nloc == 0u) { xcd_barrier_complete(bar, b.x, nloc, nx); b.st[0] = nloc; b.st[1] = nx; }
        const unsigned old = xb_add(&bar[XB_XSUB(b.x)], 1u);
        const unsigned gen = old / nloc;
        if (old + 1u == (gen + 1u) * nloc) {
            __builtin_amdgcn_fence(__ATOMIC_RELEASE, "agent");
            asm volatile("s_waitcnt vmcnt(0)" ::: "memory");
            const unsigned og = xb_add(&bar[XB_TOP], 1u);
            const unsigned tg = og / nx;
            if (og + 1u == (tg + 1u) * nx) xb_add(&bar[XB_TOPGEN], 1u);
            else XB_SPIN(xb_ld(&bar[XB_TOPGEN]) == tg, bar);
            __builtin_amdgcn_fence(__ATOMIC_ACQUIRE, "agent");
            xb_add(&bar[XB_XGEN(b.x)], 1u);
            asm volatile("s_waitcnt vmcnt(0)" ::: "memory");
        } else {
            XB_SPIN(xb_ld(&bar[XB_XGEN(b.x)]) == gen, bar);
            __builtin_amdgcn_fence(__ATOMIC_ACQUIRE, "agent");
            asm volatile("s_waitcnt vmcnt(0)" ::: "memory");
        }
    }
    __syncthreads();
}

constexpr int KROWB = 144;
constexpr int KV_ROWS = 272;
constexpr int LDS_V_OFF = KV_ROWS * KROWB;
__device__ __forceinline__ s16x4 tr_read_nw(unsigned lds_addr) { s16x4 r; asm volatile("ds_read_b64_tr_b16 %0, %1" : "=&v"(r) : "v"(lds_addr) : "memory"); return r; }
__device__ __forceinline__ s16x4 tr_read(unsigned lds_addr) { s16x4 r; asm volatile("ds_read_b64_tr_b16 %0, %1\n\ts_waitcnt lgkmcnt(0)" : "=&v"(r) : "v"(lds_addr) : "memory"); return r; }

__device__ __forceinline__ void attn_prompt(const Params& p, LAS unsigned char* lds) {
    const bf16_t* QKVG = (const bf16_t*)(p.ws + WS_QKVG);
    bf16_t* OA = (bf16_t*)(p.ws + WS_OA);
    float* OG = (float*)(p.ws + WS_OG); float* LSE = (float*)(p.ws + WS_LSE);
    const int tid = threadIdx.x, lane = tid & 63, w = tid >> 6, fr = lane & 15, fq = lane >> 4;
    const unsigned ldsK = (unsigned)(uintptr_t)lds, ldsV = ldsK + LDS_V_OFF;
    if (tid < 128) { const int row = 256 + (tid >> 3), ch = tid & 7; const u32x4 z = {0u, 0u, 0u, 0u};
        *(LAS u32x4*)(lds + row * KROWB + ch * 16) = z; *(LAS u32x4*)(lds + LDS_V_OFF + row * KROWB + ch * 16) = z; }
    constexpr int N_A = 256, N_B = 1536;
    for (int item = blockIdx.x; item < N_A + N_B; item += NWK) {
        int b, dil, r, nbk, colK, colV, colQ, nheads, maxd, head0, grp = 0, slot = 0; bool isA;
        if (item < N_A) { isA = true; b = item >> 5; const int rem = item & 31; nbk = rem >> 1; const int kvh = rem & 1; dil = 1; r = 0;
            colK = C_KA + kvh * 64; colV = C_VA + kvh * 64; head0 = kvh * 4; colQ = C_QA + head0 * 64; nheads = 4; maxd = 127; }
        else { isA = false; const int idx = item - N_A; grp = idx >> 9; const int rem = idx & 511; b = rem >> 6; const int rem2 = rem & 63; const int sub = rem2 >> 2; slot = rem2 & 3;
            dil = grp == 0 ? 1 : (grp == 1 ? 4 : 16); const int nbpr = 16 / dil; r = sub / nbpr; nbk = sub % nbpr;
            head0 = 4 * grp + slot; colK = C_KB + head0 * 64; colV = C_VB + head0 * 64; colQ = C_QB + head0 * 64; nheads = 1; maxd = 128; }
        __syncthreads();
#pragma unroll
        for (int it = 0; it < 4; ++it) {
            const int idx = tid + 512 * it, row = idx >> 3, ch = idx & 7, sk = 128 * nbk - 128 + row;
            u32x4 kv = {0u, 0u, 0u, 0u}, vv = {0u, 0u, 0u, 0u};
            if (sk >= 0) { const bf16_t* src = QKVG + (size_t)(b * SEQ + r + dil * sk) * INC; kv = *(const u32x4*)(src + colK + ch * 8); vv = *(const u32x4*)(src + colV + ch * 8); }
            *(LAS u32x4*)(lds + row * KROWB + ch * 16) = kv; *(LAS u32x4*)(lds + LDS_V_OFF + row * KROWB + ch * 16) = vv;
        }
        __syncthreads();
        const int sq = 128 * nbk + 16 * w + fr;
        const size_t grow = (size_t)(b * SEQ + r + dil * sq);
        for (int hh = 0; hh < nheads; ++hh) {
            const int head = head0 + hh;
            const float slope = isA ? ex2(-(float)(head + 1)) : ex2(-8.0f * (float)(head + 1) / 12.0f);
            const float slope2 = slope * (float)dil * LOG2E;
            const bf16_t* qp = QKVG + grow * INC + colQ + hh * 64 + fq * 8;
            const bf16x8 Q0 = *(const bf16x8*)qp, Q1 = *(const bf16x8*)(qp + 32);
            f32x4 st[10];
#pragma unroll
            for (int tl = 0; tl < 10; ++tl) {
                const LAS unsigned char* ka = lds + ((w + tl) * 16 + fr) * KROWB + fq * 16;
                const bf16x8 K0 = *(const LAS bf16x8*)ka, K1 = *(const LAS bf16x8*)(ka + 64);
                f32x4 z = {0.f, 0.f, 0.f, 0.f};
                z = __builtin_amdgcn_mfma_f32_16x16x32_bf16(K0, Q0, z, 0, 0, 0);
                st[tl] = __builtin_amdgcn_mfma_f32_16x16x32_bf16(K1, Q1, z, 0, 0, 0);
            }
            float mx = -1e30f;
#pragma unroll
            for (int tl = 0; tl < 10; ++tl)
#pragma unroll
                for (int j = 0; j < 4; ++j) {
                    const int dist = 128 + fr - tl * 16 - fq * 4 - j;
                    const int sk = 128 * nbk - 128 + (w + tl) * 16 + fq * 4 + j;
                    const bool ok = (dist >= 0) && (dist <= maxd) && (sk >= 0);
                    const float s = ok ? st[tl][j] * SC2 - slope2 * (float)dist : -1e30f;
                    st[tl][j] = s; mx = fmaxf(mx, s);
                }
            mx = fmaxf(mx, __shfl_xor(mx, 16)); mx = fmaxf(mx, __shfl_xor(mx, 32));
            float sink2 = -1e30f;
            if (isA) { sink2 = p.sinks_a[head] * LOG2E; mx = fmaxf(mx, sink2); }
            float l = 0.f;
#pragma unroll
            for (int tl = 0; tl < 10; ++tl)
#pragma unroll
                for (int j = 0; j < 4; ++j) { const float e = ex2(st[tl][j] - mx); st[tl][j] = e; l += e; }
            l += __shfl_xor(l, 16); l += __shfl_xor(l, 32);
            if (isA) l += ex2(sink2 - mx);
            f32x4 o[4];
#pragma unroll
            for (int dt = 0; dt < 4; ++dt) o[dt] = (f32x4){0.f, 0.f, 0.f, 0.f};
#pragma unroll
            for (int ks = 0; ks < 5; ++ks) {
                u32x4 pw; pw.x = pk2(st[2 * ks][0], st[2 * ks][1]); pw.y = pk2(st[2 * ks][2], st[2 * ks][3]); pw.z = pk2(st[2 * ks + 1][0], st[2 * ks + 1][1]); pw.w = pk2(st[2 * ks + 1][2], st[2 * ks + 1][3]);
                bf16x8 pf; __builtin_memcpy(&pf, &pw, 16);
                s16x4 x0[4], x1[4];
#pragma unroll
                for (int dt = 0; dt < 4; ++dt) {
                    const unsigned va = ldsV + (unsigned)(((w + 2 * ks) * 16 + fq * 4 + (fr >> 2)) * KROWB + (dt * 16 + (fr & 3) * 4) * 2);
                    x0[dt] = tr_read_nw(va); x1[dt] = tr_read_nw(va + 16 * KROWB);
                }
                asm volatile("s_waitcnt lgkmcnt(0)" : "+v"(x0[0]), "+v"(x0[1]), "+v"(x0[2]), "+v"(x0[3]), "+v"(x1[0]), "+v"(x1[1]), "+v"(x1[2]), "+v"(x1[3]) :: "memory");
#pragma unroll
                for (int dt = 0; dt < 4; ++dt) {
                    const s16x4 v0 = x0[dt], v1 = x1[dt];
                    bf16x8 vf; vf[0] = v0[0]; vf[1] = v0[1]; vf[2] = v0[2]; vf[3] = v0[3]; vf[4] = v1[0]; vf[5] = v1[1]; vf[6] = v1[2]; vf[7] = v1[3];
                    o[dt] = __builtin_amdgcn_mfma_f32_16x16x32_bf16(vf, pf, o[dt], 0, 0, 0);
                }
            }
            const float inv = 1.0f / l;
            if (isA) {
#pragma unroll
                for (int dt = 0; dt < 4; ++dt) { u32x2 ww; ww.x = pk2(o[dt][0] * inv, o[dt][1] * inv); ww.y = pk2(o[dt][2] * inv, o[dt][3] * inv);
                    *(u32x2*)(OA + grow * 768 + head * 64 + dt * 16 + fq * 4) = ww; }
            } else {
                float* og = OG + ((size_t)grp * MP + grow) * 256 + slot * 64 + fq * 4;
#pragma unroll
                for (int dt = 0; dt < 4; ++dt) *(f32x4*)(og + dt * 16) = o[dt] * inv;
                if (fq == 0) LSE[((size_t)grp * MP + grow) * 4 + slot] = (mx + __builtin_amdgcn_logf(l)) * LN2;
            }
        }
    }
}

__device__ __forceinline__ void attn_sample(const Params& p) {
    const bf16_t* QKVG = (const bf16_t*)(p.ws + WS_QKVG);
    bf16_t* OA = (bf16_t*)(p.ws + WS_OA); bf16_t* OB = (bf16_t*)(p.ws + WS_OB);
    const int tid = threadIdx.x, lane = tid & 63, wid = tid >> 6, g4 = lane >> 4, c = lane & 15;
    const int gw = blockIdx.x * 8 + wid, nw = NWK * 8;
    constexpr int N_SA = MS * 8, N_SB = MS * 4;
#pragma nounroll
    for (int item = gw; item < N_SA + N_SB; item += nw) {
        const bool isA = item < N_SA;
        const int it2 = isA ? item : item - N_SA;
        const int tok = isA ? (it2 >> 3) : (it2 >> 2), hs = isA ? (it2 & 7) : (it2 & 3), b = tok >> 2, i = tok & 3;
        const size_t row = (size_t)MP + tok, row0 = (size_t)MP + b * 4;
        float m_ = -1e30f, l_ = 0.f; f32x4 acc = {0.f, 0.f, 0.f, 0.f};
        const int nseg = isA ? 1 : 3;
#pragma nounroll
        for (int g = 0; g < nseg; ++g) {
            const int head = isA ? hs : 4 * g + hs;
            const int win = (isA || g == 0) ? 128 : (g == 1 ? 512 : 2048), dil = (isA || g == 0) ? 1 : (g == 1 ? 4 : 16);
            const int nkeys = isA ? 128 : 129;
            const float* cache = isA ? p.cache_a : (g == 0 ? p.cache_b1 : (g == 1 ? p.cache_b2 : p.cache_b3));
            const int RS = isA ? 256 : 512, VOFF = isA ? 128 : 256;
            const int kvh = isA ? (hs >> 2) : hs;
            const float* cK = cache + (size_t)b * win * RS + kvh * 64 + c * 4;
            float* oK = p.out + (isA ? O_NAS : (g == 0 ? O_NB1S : (g == 1 ? O_NB2S : O_NB3S))) + (size_t)b * win * RS + kvh * 64 + c * 4;
            const bool own_h = !isA || (hs & 3) == 0;
            const int colQ = isA ? C_QA + head * 64 : C_QB + head * 64, colK = isA ? C_KA + kvh * 64 : C_KB + head * 64, colV = isA ? C_VA + kvh * 64 : C_VB + head * 64;
            const bf16_t* nK = QKVG + row0 * INC + colK + c * 4; const bf16_t* nV = QKVG + row0 * INC + colV + c * 4;
            const u32x2 qa = *(const u32x2*)(QKVG + row * INC + colQ + c * 4);
            const f32x4 q = {bflo(qa.x), bfhi(qa.x), bflo(qa.y), bfhi(qa.y)};
            const float slope2 = (isA ? ex2(-(float)(head + 1)) : ex2(-8.0f * (float)(head + 1) / 12.0f)) * LOG2E;
            const int joff = isA ? 0 : 1;
            if (!isA) {
                const u32x2 ka = *(const u32x2*)(nK + (size_t)i * INC), va = *(const u32x2*)(nV + (size_t)i * INC);
                float s = (q[0] * bflo(ka.x) + q[1] * bfhi(ka.x)) + (q[2] * bflo(ka.y) + q[3] * bfhi(ka.y));
                s += __shfl_xor(s, 1); s += __shfl_xor(s, 2); s += __shfl_xor(s, 4); s += __shfl_xor(s, 8);
                s = (g4 == 0) ? s * SC2 : -1e30f;
                const float mn = fmaxf(m_, s), corr = ex2(m_ - mn), pe = ex2(s - mn);
                const f32x4 vself = {bflo(va.x), bfhi(va.x), bflo(va.y), bfhi(va.y)};
                m_ = mn; l_ = l_ * corr + pe; acc = acc * corr + vself * pe;
            }
#pragma nounroll
            for (int j0 = joff; j0 < nkeys; j0 += 64) {
                f32x4 kk[16], vv[16];
#pragma unroll
                for (int u = 0; u < 16; ++u) {
                    const int jj = j0 + u * 4 + g4; const int f = win + i - jj * dil;
                    kk[u] = (f32x4){0.f, 0.f, 0.f, 0.f}; vv[u] = kk[u];
                    if (jj < nkeys) {
                        if (f >= win) { const u32x2 a = *(const u32x2*)(nK + (size_t)(f - win) * INC), bb = *(const u32x2*)(nV + (size_t)(f - win) * INC);
                            kk[u] = (f32x4){bflo(a.x), bfhi(a.x), bflo(a.y), bfhi(a.y)}; vv[u] = (f32x4){bflo(bb.x), bfhi(bb.x), bflo(bb.y), bfhi(bb.y)}; }
                        else { kk[u] = *(const f32x4*)(cK + (size_t)f * RS); vv[u] = *(const f32x4*)(cK + (size_t)f * RS + VOFF); }
                    }
                }
#pragma unroll
                for (int u = 0; u < 16; ++u) {
                    const int jj = j0 + u * 4 + g4; const int f = win + i - jj * dil;
                    if (jj < nkeys && f < win && f >= 4 && own_h && (dil != 1 || (f & 3) == i)) { *(f32x4*)(oK + (size_t)(f - 4) * RS) = kk[u]; *(f32x4*)(oK + (size_t)(f - 4) * RS + VOFF) = vv[u]; }
                }
#pragma unroll
                for (int u = 0; u < 16; ++u) {
                    const int jj = j0 + u * 4 + g4;
                    float s = (q[0] * kk[u][0] + q[1] * kk[u][1]) + (q[2] * kk[u][2] + q[3] * kk[u][3]);
                    s += __shfl_xor(s, 1); s += __shfl_xor(s, 2); s += __shfl_xor(s, 4); s += __shfl_xor(s, 8);
                    s = (jj < nkeys) ? s * SC2 - slope2 * (float)(jj * dil) : -1e30f;
                    const float mn = fmaxf(m_, s), corr = ex2(m_ - mn), pe = ex2(s - mn);
                    m_ = mn; l_ = l_ * corr + pe; acc = acc * corr + vv[u] * pe;
                }
            }
        }
        float M = fmaxf(m_, __shfl_xor(m_, 16)); M = fmaxf(M, __shfl_xor(M, 32));
        float sink2 = -1e30f;
        if (isA) { sink2 = p.sinks_a[hs] * LOG2E; M = fmaxf(M, sink2); }
        const float cf = ex2(m_ - M); float l = l_ * cf; f32x4 a = acc * cf;
        l += __shfl_xor(l, 16); l += __shfl_xor(l, 32);
#pragma unroll
        for (int e = 0; e < 4; ++e) { a[e] += __shfl_xor(a[e], 16); a[e] += __shfl_xor(a[e], 32); }
        if (isA) l += ex2(sink2 - M);
        const float inv = 1.0f / l;
        if (g4 == 0) { u32x2 ww; ww.x = pk2(a[0] * inv, a[1] * inv); ww.y = pk2(a[2] * inv, a[3] * inv);
            bf16_t* o = isA ? OA + row * 768 + hs * 64 + c * 4 : OA + row * 768 + 512 + hs * 64 + c * 4; *(u32x2*)o = ww; }
    }
}

__device__ __forceinline__ void write_new_rows(const bf16_t* QKVG, float* out, int nb, int Wout, int first, int nrows, int src0, int src_per_b, int colK, int colV, int ncols, size_t gtid, size_t gth) {
    const int c8n = ncols / 8; const size_t total = (size_t)nb * nrows * 2 * c8n;
    for (size_t i = gtid; i < total; i += gth) {
        const int c8 = (int)(i % c8n); size_t t = i / c8n; const int kv = (int)(t & 1); t >>= 1; const int r = (int)(t % nrows); const int b = (int)(t / nrows);
        const u32x4 v = *(const u32x4*)(QKVG + (size_t)(src0 + b * src_per_b + r) * INC + (kv ? colV : colK) + c8 * 8);
        float* o = out + (((size_t)b * Wout + first + r) * 2 + kv) * ncols + c8 * 8;
        *(f32x4*)o = (f32x4){bflo(v.x), bfhi(v.x), bflo(v.y), bfhi(v.y)}; *(f32x4*)(o + 4) = (f32x4){bflo(v.z), bfhi(v.z), bflo(v.w), bfhi(v.w)};
    }
}
__device__ __forceinline__ void phase_attention(const Params& p, LAS unsigned char* lds) {
#ifndef NO_AP
    attn_prompt(p, lds);
#ifdef DBL_AP
    attn_prompt(p, lds);
#endif
#endif
#ifndef NO_AS
    attn_sample(p);
#ifdef DBL_AS
    attn_sample(p);
#endif
#endif
    const bf16_t* QKVG = (const bf16_t*)(p.ws + WS_QKVG);
    const size_t gtid = (size_t)blockIdx.x * 512 + threadIdx.x, gth = (size_t)NWK * 512;
    write_new_rows(QKVG, p.out + O_NAP, NBATCH, 128, 0, 128, SEQ - 128, SEQ, C_KA, C_VA, 128, gtid, gth);
    write_new_rows(QKVG, p.out + O_NB1P, NBATCH, 128, 0, 128, SEQ - 128, SEQ, C_KB, C_VB, 256, gtid, gth);
    write_new_rows(QKVG, p.out + O_NB2P, NBATCH, 512, 0, 512, SEQ - 512, SEQ, C_KB + 256, C_VB + 256, 256, gtid, gth);
    write_new_rows(QKVG, p.out + O_NB3P, NBATCH, 2048, 0, 2048, 0, SEQ, C_KB + 512, C_VB + 512, 256, gtid, gth);
    write_new_rows(QKVG, p.out + O_NAS, DBATCH, 128, 124, 4, MP, 4, C_KA, C_VA, 128, gtid, gth);
    write_new_rows(QKVG, p.out + O_NB1S, DBATCH, 128, 124, 4, MP, 4, C_KB, C_VB, 256, gtid, gth);
    write_new_rows(QKVG, p.out + O_NB2S, DBATCH, 512, 508, 4, MP, 4, C_KB + 256, C_VB + 256, 256, gtid, gth);
    write_new_rows(QKVG, p.out + O_NB3S, DBATCH, 2048, 2044, 4, MP, 4, C_KB + 512, C_VB + 512, 256, gtid, gth);
}
__device__ __forceinline__ void phase_combine(const Params& p) {
    const float* OG = (const float*)(p.ws + WS_OG); const float* LSE = (const float*)(p.ws + WS_LSE); bf16_t* OB = (bf16_t*)(p.ws + WS_OA);
    const size_t gtid = (size_t)blockIdx.x * 512 + threadIdx.x, gth = (size_t)NWK * 512;
    for (size_t i = gtid; i < (size_t)MP * 64; i += gth) {
        const size_t row = i >> 6; const int c4 = (int)(i & 63), slot = c4 >> 4;
        const float l0 = LSE[row * 4 + slot], l1 = LSE[((size_t)MP + row) * 4 + slot], l2 = LSE[((size_t)2 * MP + row) * 4 + slot];
        const float mm = fmaxf(l0, fmaxf(l1, l2));
        float w0 = ex2((l0 - mm) * LOG2E), w1 = ex2((l1 - mm) * LOG2E), w2 = ex2((l2 - mm) * LOG2E);
        const float inv = 1.0f / (w0 + w1 + w2); w0 *= inv; w1 *= inv; w2 *= inv;
        const f32x4 a = *(const f32x4*)(OG + row * 256 + c4 * 4), bq = *(const f32x4*)(OG + ((size_t)MP + row) * 256 + c4 * 4), cq = *(const f32x4*)(OG + ((size_t)2 * MP + row) * 256 + c4 * 4);
        const f32x4 o = a * w0 + bq * w1 + cq * w2;
        u32x2 ww; ww.x = pk2(o[0], o[1]); ww.y = pk2(o[2], o[3]);
        *(u32x2*)(OB + row * 768 + 512 + c4 * 4) = ww;
    }
}
constexpr int KS5 = 4, KS9 = 16;
__device__ __forceinline__ void phase_norm_mid(const Params& p) {
    const bf16_t* MIX = (const bf16_t*)(p.ws + WS_T1); const float* PART = (const float*)(p.ws + WS_PART); float* X1 = (float*)(p.ws + WS_X1); bf16_t* H2 = (bf16_t*)(p.ws + WS_H);
    const int lane = threadIdx.x & 63, wid = threadIdx.x >> 6, gw = blockIdx.x * 8 + wid, nw = NWK * 8;
    for (int row = gw; row < MT; row += nw) {
        const float* xr = row < MP ? p.x_prompt + (size_t)row * DM : p.x_sample + (size_t)(row - MP) * DM;
        f32x4 mv[4], xv[4]; float s = 0.f;
#pragma unroll
        for (int j = 0; j < 4; ++j) {
            if (row < MP) { const u32x2 wv = ((const u32x2*)(MIX + (size_t)row * DM))[lane + 64 * j]; mv[j] = (f32x4){bflo(wv.x), bfhi(wv.x), bflo(wv.y), bfhi(wv.y)}; }
            else { mv[j] = (f32x4){0.f, 0.f, 0.f, 0.f};
#pragma unroll
                for (int sl = 0; sl < KS5; ++sl) mv[j] += ((const f32x4*)(PART + ((size_t)sl * MS + (row - MP)) * DM))[lane + 64 * j]; }
            xv[j] = ((const f32x4*)xr)[lane + 64 * j];
            s += (mv[j][0] * mv[j][0] + mv[j][1] * mv[j][1]) + (mv[j][2] * mv[j][2] + mv[j][3] * mv[j][3]); }
        const float r1 = rsqrtf(wave_sum(s) * (1.0f / DM) + RMS_EPS);
        float s2 = 0.f;
#pragma unroll
        for (int j = 0; j < 4; ++j) { const f32x4 g = ((const f32x4*)p.g_mix_post)[lane + 64 * j]; xv[j] = xv[j] + mv[j] * r1 * g;
            s2 += (xv[j][0] * xv[j][0] + xv[j][1] * xv[j][1]) + (xv[j][2] * xv[j][2] + xv[j][3] * xv[j][3]);
            ((f32x4*)(X1 + (size_t)row * DM))[lane + 64 * j] = xv[j]; }
        const float r2 = rsqrtf(wave_sum(s2) * (1.0f / DM) + RMS_EPS);
#pragma unroll
        for (int j = 0; j < 4; ++j) { const f32x4 g = ((const f32x4*)p.g_ffn_pre)[lane + 64 * j];
            u32x2 o; o.x = pk2(xv[j][0] * r2 * g[0], xv[j][1] * r2 * g[1]); o.y = pk2(xv[j][2] * r2 * g[2], xv[j][3] * r2 * g[3]);
            *(u32x2*)(H2 + (size_t)row * DM + (lane + 64 * j) * 4) = o; }
    }
}
__device__ __forceinline__ float gelu_tanh(float x) {
    const float t = 0.7978845608028654f * (x + 0.044715f * x * x * x);
    const float e = ex2(2.0f * LOG2E * t);
    const float th = 1.0f - 2.0f / (1.0f + e);
    return 0.5f * x * (1.0f + th);
}
__device__ __forceinline__ void ld8(const bf16_t* ptr, float (&o)[8]) {
    const u32x4 v = *(const u32x4*)ptr; o[0] = bflo(v.x); o[1] = bfhi(v.x); o[2] = bflo(v.y); o[3] = bfhi(v.y); o[4] = bflo(v.z); o[5] = bfhi(v.z); o[6] = bflo(v.w); o[7] = bfhi(v.w);
}
__device__ __forceinline__ void ld8f(const float* ptr, float (&o)[8]) {
    const f32x4 a = *(const f32x4*)ptr, b = *(const f32x4*)(ptr + 4); o[0] = a[0]; o[1] = a[1]; o[2] = a[2]; o[3] = a[3]; o[4] = b[0]; o[5] = b[1]; o[6] = b[2]; o[7] = b[3];
}
__device__ __forceinline__ void phase_conv(const Params& p) {
    const bf16_t* AG = (const bf16_t*)(p.ws + WS_AG); bf16_t* U = (bf16_t*)(p.ws + WS_U);
    const size_t gtid = (size_t)blockIdx.x * 512 + threadIdx.x, gth = (size_t)NWK * 512;
    for (size_t i = gtid; i < (size_t)NBATCH * 2 * 512; i += gth) {
        const int f0 = (int)(i & 511) * 8, k = (int)(i >> 9) & 1, b = (int)(i >> 10);
        float a2[8]; ld8(AG + (size_t)(b * SEQ + SEQ - 2 + k) * 8192 + f0, a2);
        float* o = p.out + O_NCP + ((size_t)b * 2 + k) * DFF + f0;
        *(f32x4*)o = (f32x4){a2[0], a2[1], a2[2], a2[3]}; *(f32x4*)(o + 4) = (f32x4){a2[4], a2[5], a2[6], a2[7]};
    }
    for (size_t i = gtid; i < (size_t)(MS + 2 * (MP / 256)) * 512; i += gth) {
        const int ri = (int)(i >> 9), f0 = (int)(i & 511) * 8;
        const int row = ri < MS ? MP + ri : ((ri - MS) >> 1) * 256 + ((ri - MS) & 1);
        float a0[8], a1[8], a2[8], g[8], w0[8], w1[8], w2[8], cb[8];
        ld8(AG + (size_t)row * 8192 + f0, a2); ld8(AG + (size_t)row * 8192 + DFF + f0, g);
        ld8f(p.conv_w + f0, w0); ld8f(p.conv_w + DFF + f0, w1); ld8f(p.conv_w + 2 * DFF + f0, w2); ld8f(p.conv_b + f0, cb);
        if (row < MP) {
            const int pos = row & (SEQ - 1);
            if (pos >= 1) ld8(AG + (size_t)(row - 1) * 8192 + f0, a1); else { for (int e = 0; e < 8; ++e) a1[e] = 0.f; }
            if (pos >= 2) ld8(AG + (size_t)(row - 2) * 8192 + f0, a0); else { for (int e = 0; e < 8; ++e) a0[e] = 0.f; }
        } else {
            const int sr = row - MP, b = sr >> 2, pos = sr & 3;
            const float* stc = p.state_conv + (size_t)b * 2 * DFF + f0;
            if (pos >= 1) ld8(AG + (size_t)(row - 1) * 8192 + f0, a1); else ld8f(stc + DFF, a1);
            if (pos >= 2) ld8(AG + (size_t)(row - 2) * 8192 + f0, a0); else ld8f(stc + (size_t)pos * DFF, a0);
            if (pos >= 2) { float* o = p.out + O_NCS + ((size_t)b * 2 + (pos - 2)) * DFF + f0;
                *(f32x4*)o = (f32x4){a2[0], a2[1], a2[2], a2[3]}; *(f32x4*)(o + 4) = (f32x4){a2[4], a2[5], a2[6], a2[7]}; }
        }
        float uo[8];
#pragma unroll
        for (int e = 0; e < 8; ++e) { const float cv = cb[e] + w0[e] * a0[e] + w1[e] * a1[e] + w2[e] * a2[e]; uo[e] = gelu_tanh(cv) * g[e]; }
        u32x4 w; w.x = pk2(uo[0], uo[1]); w.y = pk2(uo[2], uo[3]); w.z = pk2(uo[4], uo[5]); w.w = pk2(uo[6], uo[7]);
        *(u32x4*)(U + (size_t)row * DFF + f0) = w;
    }
}
__device__ __forceinline__ void phase_norm_out(const Params& p) {
    const bf16_t* F = (const bf16_t*)(p.ws + WS_T1); const float* X1 = (const float*)(p.ws + WS_X1); const float* PART = (const float*)(p.ws + WS_PART);
    const int lane = threadIdx.x & 63, wid = threadIdx.x >> 6, gw = blockIdx.x * 8 + wid, nw = NWK * 8;
    for (int row = gw; row < MT; row += nw) {
        f32x4 fv[4]; float s = 0.f;
#pragma unroll
        for (int j = 0; j < 4; ++j) {
            if (row < MP) { const u32x2 wv = ((const u32x2*)(F + (size_t)row * DM))[lane + 64 * j]; fv[j] = (f32x4){bflo(wv.x), bfhi(wv.x), bflo(wv.y), bfhi(wv.y)}; }
            else { fv[j] = (f32x4){0.f, 0.f, 0.f, 0.f};
#pragma unroll
                for (int sl = 0; sl < KS9; ++sl) fv[j] += ((const f32x4*)(PART + ((size_t)sl * MS + (row - MP)) * DM))[lane + 64 * j]; }
            s += (fv[j][0] * fv[j][0] + fv[j][1] * fv[j][1]) + (fv[j][2] * fv[j][2] + fv[j][3] * fv[j][3]); }
        const float r1 = rsqrtf(wave_sum(s) * (1.0f / DM) + RMS_EPS);
#pragma unroll
        for (int j = 0; j < 4; ++j) { const f32x4 g = ((const f32x4*)p.g_ffn_post)[lane + 64 * j]; const f32x4 x = ((const f32x4*)(X1 + (size_t)row * DM))[lane + 64 * j];
            ((f32x4*)(p.out + O_Y + (size_t)row * DM))[lane + 64 * j] = x + fv[j] * r1 * g; }
    }
}

constexpr int N_PHASES = 11;
#ifndef NW_P1
#define NW_P1 256
#endif
#ifndef NW_P7
#define NW_P7 256
#endif
constexpr int LDS_BYTES = pg8::STAGE_BYTES + 16 + 4096;
__global__ void __launch_bounds__(512, 2) fwd_kernel(Params p) {
    extern __shared__ __attribute__((aligned(16))) unsigned char lds_raw[];
    LAS unsigned char* lds = (LAS unsigned char*)lds_raw;
    cg::grid_group grid = cg::this_grid();
    unsigned char* ws = p.ws;
    const bf16_t* QKVG = (const bf16_t*)(ws + WS_QKVG);
#ifndef PHMASK
#define PHMASK 0x7ff
#endif
#ifndef REPLAY_HI
#define REPLAY_HI 0
#endif
#define PH(k) (((PHMASK >> (k)) & 1) && p.ph_lo <= (k) && (k) < p.ph_hi)
    volatile LAS unsigned* bst = (volatile LAS unsigned*)(lds + pg8::STAGE_BYTES);
    if (threadIdx.x < 4) bst[threadIdx.x] = 0u;
    __syncthreads();
    const XcdBarrier xbar = xcd_barrier_post((unsigned*)(ws + WS_BAR + (size_t)p.bar_sel * 16384), bst);
    if (p.ph_lo < 0) grid.sync();
#define SEAM(k) do { if ((k) + 1 < p.ph_hi) xcd_barrier(xbar); } while (0)
#ifndef DBLMASK
#define DBLMASK 0
#endif
#define REP(k) for (int rep_ = 0; rep_ < 1 + ((DBLMASK >> (k)) & 1); ++rep_)
    const bool cw = (int)blockIdx.x >= NWK;
    if (PH(0)) { if (cw) copy_dedicated(p, 0, NWK); else { REP(0) phase_prologue(p, lds); signal_done(p, 0); } SEAM(0); }
    if (PH(1)) { if (cw) copy_dedicated(p, 1, NWK); else { REP(1) { EpiStoreQkvg e; e.O = (bf16_t*)(ws + WS_QKVG); run_gemm(lds, (const bf16_t*)(ws + WS_H), (const bf16_t*)(ws + WS_WIN), MT, INC, DM, e, NWK); } copy_helper(p, lds, 1, NWK, true); } SEAM(1); }
    if (PH(2)) { if (cw) copy_dedicated(p, 2, NWK); else { REP(2) phase_attention(p, lds); signal_done(p, 2); } SEAM(2); }
    if (PH(3)) { if (cw) copy_dedicated(p, 3, NWK); else { REP(3) phase_combine(p); copy_helper(p, lds, 3, 0u, true, 1); } SEAM(3); }
    if (PH(4)) { if (cw) copy_dedicated(p, 4, NWK); else { REP(4) { EpiGateAB e; e.T1 = (bf16_t*)(ws + WS_T1); e.QKVG = QKVG; e.O = (bf16_t*)(ws + WS_H);
        pg8::Gemm g; g.A = (const bf16_t*)(ws + WS_OA); g.Bt = (const bf16_t*)(ws + WS_WA); g.M = MT; g.N = DM; g.K = 768;
        PairOrder S; S.init(NWK, (int)blockIdx.x);
        pg8::gemm_phase<EpiGateAB, PairOrder, true, true>(lds, g, S, e);
        } copy_helper(p, lds, 4, NWK, true); } SEAM(4); }
    if (PH(5)) { REP(5) { EpiStoreF32Split e; e.O = (bf16_t*)(ws + WS_T1); e.PART = (float*)(ws + WS_PART); e.kslice = DM / KS5; run_gemm_split(lds, (const bf16_t*)(ws + WS_H), (const bf16_t*)(ws + WS_WOUT), DM, DM, KS5, e); } copy_helper(p, lds, 5, gridDim.x, true); SEAM(5); }
    if (PH(6)) { if (cw) copy_dedicated(p, 6, NWK); else { REP(6) phase_norm_mid(p); signal_done(p, 6); } SEAM(6); }
    if (PH(7)) { if (cw) copy_dedicated(p, 7, NWK); else { REP(7) { EpiConvGelu e; e.U = (bf16_t*)(ws + WS_U); e.AG = (bf16_t*)(ws + WS_AG); e.conv_w = p.conv_w; e.conv_b = p.conv_b; e.hal = (LAS float*)(lds + LDS_HALO_OFF); run_gemm(lds, (const bf16_t*)(ws + WS_H), (const bf16_t*)(ws + WS_WUP), MT, 2 * DFF, DM, e, NWK); } copy_helper(p, lds, 7, NWK, true); } SEAM(7); }
    if (PH(8)) { if (cw) copy_dedicated(p, 8, NWK); else { REP(8) phase_conv(p); signal_done(p, 8); } SEAM(8); }
    if (PH(9)) { REP(9) { EpiStoreF32Split e; e.O = (bf16_t*)(ws + WS_T1); e.PART = (float*)(ws + WS_PART); e.kslice = DFF / KS9; run_gemm_split(lds, (const bf16_t*)(ws + WS_U), (const bf16_t*)(ws + WS_WDN), DM, DFF, KS9, e); } copy_helper(p, lds, 9, gridDim.x, true); SEAM(9); }
    if (PH(10)) { if (!cw) { REP(10) phase_norm_out(p); } copy_helper(p, lds, 10, 0u, false, 2); }
}

#ifndef MK_SINGLE
#define MK_SINGLE 1
#endif
extern "C" void kernel_launch(void* const* d_in, const int* in_sizes, int n_in, void* d_out, int out_size, void* d_ws, size_t ws_size, hipStream_t stream) {
    static int grid = 0;
    if (grid == 0) {
        if (n_in != 20 || (size_t)out_size != O_END || ws_size < WS_END) { fprintf(stderr, "kernel_launch: unexpected shapes: n_in %d out %d ws %zu (need %zu)\n", n_in, out_size, ws_size, (size_t)WS_END); grid = -1; return; }
        int dev = 0, cus = 0, per_cu = 0;
        hipGetDevice(&dev); hipDeviceGetAttribute(&cus, hipDeviceAttributeMultiprocessorCount, dev);
        if (hipFuncSetAttribute((const void*)fwd_kernel, hipFuncAttributeMaxDynamicSharedMemorySize, LDS_BYTES) != hipSuccess) { fprintf(stderr, "kernel_launch: hipFuncSetAttribute failed\n"); grid = -1; return; }
        if (hipOccupancyMaxActiveBlocksPerMultiprocessor(&per_cu, (const void*)fwd_kernel, 512, LDS_BYTES) != hipSuccess || per_cu < 1) { fprintf(stderr, "kernel_launch: occupancy query says %d\n", per_cu); per_cu = 1; }
        (void)hipGetLastError();
        grid = cus * 1;
    }
    if (grid < 0) return;
    if (hipMemsetAsync((char*)d_ws + WS_CTL, 0, WS_END - WS_CTL, stream) != hipSuccess) { fprintf(stderr, "kernel_launch: memset of control words failed\n"); return; }
    Params p{};
    const float** pp = (const float**)&p;
    for (int i = 0; i < 20; ++i) pp[i] = (const float*)d_in[i];
    p.out = (float*)d_out; p.ws = (unsigned char*)d_ws;
#if MK_SINGLE
    p.ph_lo = 0; p.ph_hi = N_PHASES;
    void* args[] = {&p};
    hipError_t e = hipLaunchCooperativeKernel((const void*)fwd_kernel, dim3(grid), dim3(512), args, LDS_BYTES, stream);
    if (e != hipSuccess) fprintf(stderr, "cooperative launch failed: %s (grid %d)\n", hipGetErrorString(e), grid);
#if REPLAY_HI > 0
    p.ph_lo = 0; p.ph_hi = REPLAY_HI; p.bar_sel = 1;
    e = hipLaunchCooperativeKernel((const void*)fwd_kernel, dim3(grid), dim3(512), args, LDS_BYTES, stream);
#endif
#else
    for (int ph = 0; ph < N_PHASES; ++ph) {
        p.ph_lo = ph; p.ph_hi = ph + 1;
        hipLaunchKernelGGL(fwd_kernel, dim3(grid), dim3(512), LDS_BYTES, stream, p);
    }
#endif
}
```
